# Optimizing an MI355X kernel written in HIP

```python
import math
import jax
import jax.numpy as jnp
from jax import lax
import numpy as np

D_MODEL = 1024
BATCH = 8
SEQ = 4096
DEPTH = 2

CTX_LEN = 256
GRID_W = 64
HEAD_DIM = 64
H_RET = 4
H_GDN = 4
H_NA = 8
D_RET = H_RET * HEAD_DIM
D_GDN = H_GDN * HEAD_DIM
D_NA = H_NA * HEAD_DIM
D_MIX = D_RET + D_GDN + D_NA
RET_COLS = 4 * D_RET
GDN_COLS = 4 * D_GDN + 4 * H_GDN
NA_COLS = 3 * D_NA
D_IN = RET_COLS + GDN_COLS + NA_COLS
RET_CHUNK = 128
GDN_CHUNK = 64
SHORT_CONV = 5
NA_KH = 8
NA_KW = 16
NA_QBLK = 16
NA_KBLK = 32
N_COLBLK = GRID_W // NA_QBLK
ROPE_BASE = 10000.0
N_FREQ = HEAD_DIM // 4
D_FF = 2816
N_EXPERTS = 8
TOP_K = 2
MOE_BLOCK = 128
EPS = 1e-6
NEG_INF = -1e30

kernel_name = 'hybrid_dit_retention_gdn_natten_moe'


def rms_norm(x, g):
    xf = x.astype(jnp.float32)
    y = xf * lax.rsqrt(jnp.mean(xf * xf, axis=-1, keepdims=True) + EPS)
    return (y * g.astype(jnp.float32)).astype(x.dtype)


def modulate(h, shift, scale):
    return h * (1 + scale) + shift


def head_rms(o):
    return o * lax.rsqrt(jnp.mean(o * o, axis=-1, keepdims=True) + EPS)


def l2_normalise(t):
    return t * lax.rsqrt(jnp.sum(t * t, axis=-1, keepdims=True) + EPS)


def split_heads(t, n_heads):
    return t.reshape(t.shape[:-1] + (n_heads, HEAD_DIM))


def merge_heads(t):
    return t.reshape(t.shape[:-2] + (-1,))


def axial_rope_tables(n_tok):
    t = jnp.arange(n_tok, dtype=jnp.int32)
    row = (t // GRID_W).astype(jnp.float32)
    col = (t % GRID_W).astype(jnp.float32)
    inv_freq = ROPE_BASE ** (-jnp.arange(N_FREQ, dtype=jnp.float32) / N_FREQ)
    ang = jnp.concatenate([row[:, None] * inv_freq, col[:, None] * inv_freq], axis=-1)
    return jnp.cos(ang)[:, None, :], jnp.sin(ang)[:, None, :]


def apply_rope(t, cos, sin):
    t1, t2 = jnp.split(t, 2, axis=-1)
    return jnp.concatenate([t1 * cos - t2 * sin, t1 * sin + t2 * cos], axis=-1)


def centred_depthwise_conv(t, w):
    k_w, ch = w.shape
    return lax.conv_general_dilated(t, w[:, None, :].astype(t.dtype), window_strides=(1,),
                                    padding=[(k_w // 2, k_w // 2)],
                                    dimension_numbers=('NWC', 'WIO', 'NWC'), feature_group_count=ch)


def to_chunks(t, chunk):
    b, l, h = t.shape[:3]
    t = t.reshape((b, l // chunk, chunk, h) + t.shape[3:])
    return jnp.moveaxis(t, (1, 3), (0, 2))


def from_chunks(t):
    t = jnp.moveaxis(t, (0, 2), (1, 3))
    return t.reshape((t.shape[0], t.shape[1] * t.shape[2]) + t.shape[3:])


def retention_scan(q, k, v, log_gamma, s0):
    pos = jnp.arange(RET_CHUNK, dtype=jnp.float32)
    diff = pos[:, None] - pos[None, :]
    intra_decay = jnp.where(diff >= 0, jnp.exp(log_gamma[:, None, None] * jnp.maximum(diff, 0.0)), 0.0)
    q_decay = jnp.exp(log_gamma[:, None] * (pos + 1.0))[..., None]
    k_decay = jnp.exp(log_gamma[:, None] * (RET_CHUNK - 1.0 - pos))[..., None]
    chunk_decay = jnp.exp(log_gamma * RET_CHUNK)[:, None, None]

    def step(s, inp):
        qi, ki, vi = inp
        scores = jnp.einsum('bhid,bhjd->bhij', qi, ki) * intra_decay
        o = jnp.einsum('bhij,bhje->bhie', scores, vi) + jnp.einsum('bhid,bhde->bhie', qi * q_decay, s)
        s = s * chunk_decay + jnp.einsum('bhjd,bhje->bhde', ki * k_decay, vi)
        return s, o

    s_fin, o = lax.scan(step, s0, (to_chunks(q, RET_CHUNK), to_chunks(k, RET_CHUNK), to_chunks(v, RET_CHUNK)))
    return from_chunks(o), s_fin


def gated_delta_scan(q, k, v, g, beta, s0):
    c = GDN_CHUNK
    pos = jnp.arange(c)
    incl = pos[:, None] >= pos[None, :]
    strict = pos[:, None] > pos[None, :]

    def step(s, inp):
        qi, ki, vi, gi, bi = inp
        diff = gi[..., :, None] - gi[..., None, :]
        decay = jnp.where(incl, jnp.exp(jnp.where(incl, diff, 0.0)), 0.0)
        kb = ki * bi[..., None]
        a = jnp.where(strict, jnp.einsum('bhid,bhjd->bhij', kb, ki) * decay, 0.0)
        rhs = jnp.concatenate([vi * bi[..., None], kb * jnp.exp(gi)[..., None]], axis=-1)
        sol = lax.linalg.triangular_solve(a, rhs, left_side=True, lower=True, unit_diagonal=True)
        u, w = jnp.split(sol, 2, axis=-1)
        v_new = u - jnp.einsum('bhcd,bhde->bhce', w, s)
        attn = jnp.einsum('bhid,bhjd->bhij', qi, ki) * decay
        o = (jnp.einsum('bhid,bhde->bhie', qi * jnp.exp(gi)[..., None], s)
             + jnp.einsum('bhij,bhje->bhie', attn, v_new))
        g_last = gi[..., -1:]
        s = (s * jnp.exp(g_last)[..., None]
             + jnp.einsum('bhjd,bhje->bhde', ki * jnp.exp(g_last - gi)[..., None], v_new))
        return s, o

    g_cum = jnp.cumsum(to_chunks(g, c), axis=-1)
    s_fin, o = lax.scan(step, s0, (to_chunks(q, c), to_chunks(k, c), to_chunks(v, c), g_cum, to_chunks(beta, c)))
    return from_chunks(o), s_fin


def bidirectional(scan_fw, scan_bw, lat, ctx, s0):
    rev = lambda ts: tuple(jnp.flip(t, axis=1) for t in ts)
    oc_f, sc_f = scan_fw(ctx, s0)
    oc_b, sc_b = scan_bw(rev(ctx), s0)
    ol_f, _ = scan_fw(lat, sc_f)
    ol_b, _ = scan_bw(rev(lat), sc_b)
    return ol_f + jnp.flip(ol_b, axis=1), oc_f + jnp.flip(oc_b, axis=1)


def retention_group(pl, pc, decay_param, cos, sin, need_ctx):
    log_gamma = jnp.log1p(-jnp.exp2(-decay_param.astype(jnp.float32)))

    def prep(p, rotate):
        q, k, v, gate = [split_heads(t.astype(jnp.float32), H_RET) for t in jnp.split(p, 4, axis=-1)]
        if rotate:
            q, k = apply_rope(q, cos, sin), apply_rope(k, cos, sin)
        return (q, k * HEAD_DIM ** -0.5, v), gate

    lat, gate_l = prep(pl, True)
    ctx, gate_c = prep(pc, False)
    s0 = jnp.zeros((pl.shape[0], H_RET, HEAD_DIM, HEAD_DIM), jnp.float32)
    o_l, o_c = bidirectional(lambda seq, s: retention_scan(*seq, log_gamma[0], s),
                             lambda seq, s: retention_scan(*seq, log_gamma[1], s), lat, ctx, s0)
    finish = lambda o, gate: merge_heads(head_rms(o) * jax.nn.silu(gate))
    out_c = finish(o_c, gate_c).astype(pc.dtype) if need_ctx else None
    return finish(o_l, gate_l).astype(pl.dtype), out_c


def gdn_group(pl, pc, conv_w, a_log, dt_bias, norm_g, need_ctx):
    a_log = a_log.astype(jnp.float32)
    dt_bias = dt_bias.astype(jnp.float32)

    def prep(p):
        p = p.astype(jnp.float32)
        qkv = jax.nn.silu(centred_depthwise_conv(p[..., :3 * D_GDN], conv_w))
        q, k, v = [split_heads(t, H_GDN) for t in jnp.split(qkv, 3, axis=-1)]
        gate = split_heads(p[..., 3 * D_GDN:4 * D_GDN], H_GDN)
        ab = p[..., 4 * D_GDN:].reshape(p.shape[:2] + (2, 2, H_GDN))
        g = -jnp.exp(a_log) * jax.nn.softplus(ab[:, :, 0] + dt_bias)
        beta = jax.nn.sigmoid(ab[:, :, 1])
        return (l2_normalise(q) * HEAD_DIM ** -0.5, l2_normalise(k), v, g, beta), gate

    lat, gate_l = prep(pl)
    ctx, gate_c = prep(pc)
    s0 = jnp.zeros((pl.shape[0], H_GDN, HEAD_DIM, HEAD_DIM), jnp.float32)

    def scan_dir(dr):
        return lambda seq, s: gated_delta_scan(seq[0], seq[1], seq[2], seq[3][:, :, dr], seq[4][:, :, dr], s)

    o_l, o_c = bidirectional(scan_dir(0), scan_dir(1), lat, ctx, s0)
    finish = lambda o, gate: merge_heads(head_rms(o) * norm_g.astype(jnp.float32) * jax.nn.silu(gate))
    out_c = finish(o_c, gate_c).astype(pc.dtype) if need_ctx else None
    return finish(o_l, gate_l).astype(pl.dtype), out_c


def neighbourhood_attention(ql, kl, vl, kc, vc, rpb):
    b, l, h, d = ql.shape
    rows = l // GRID_W
    kh = min(NA_KH, rows)
    scale = d ** -0.5
    qg = ql.reshape(b, rows, GRID_W, h, d)
    kg = kl.reshape(b, rows, GRID_W, h, d)
    vg = vl.reshape(b, rows, GRID_W, h, d)
    kcf = kc.astype(jnp.float32)
    vcf = vc.astype(jnp.float32)
    qcol = jnp.arange(GRID_W, dtype=jnp.int32).reshape(N_COLBLK, NA_QBLK)
    win_start = jnp.clip(qcol - NA_KW // 2, 0, GRID_W - NA_KW)
    band_start = jnp.clip(qcol[:, 0] - NA_KW // 2, 0, GRID_W - NA_KBLK)
    band_cols = band_start[:, None] + jnp.arange(NA_KBLK, dtype=jnp.int32)
    kcol = band_cols[:, None, :]
    col_ok = (kcol >= win_start[..., None]) & (kcol < win_start[..., None] + NA_KW)
    col_idx = jnp.clip(kcol - qcol[..., None] + NA_KW - 1, 0, 2 * NA_KW - 2)
    rpb_c = rpb.astype(jnp.float32)[:, :, col_idx]

    def one_row(r):
        r0 = jnp.clip(r - kh // 2, 0, rows - kh)
        qb = lax.dynamic_index_in_dim(qg, r, axis=1, keepdims=False)
        qb = qb.reshape(b, N_COLBLK, NA_QBLK, h, d).astype(jnp.float32)
        kr = lax.dynamic_slice_in_dim(kg, r0, kh, axis=1)[:, :, band_cols].astype(jnp.float32)
        vr = lax.dynamic_slice_in_dim(vg, r0, kh, axis=1)[:, :, band_cols].astype(jnp.float32)
        s_loc = jnp.einsum('bnqhd,binkhd->bhnqik', qb, kr) * scale
        row_idx = r0 + jnp.arange(kh, dtype=jnp.int32) - r + NA_KH - 1
        bias = jnp.transpose(rpb_c[:, row_idx], (0, 2, 3, 1, 4))
        s_loc = jnp.where(col_ok[:, :, None, :], s_loc + bias, NEG_INF)
        s_ctx = jnp.einsum('bnqhd,bchd->bhnqc', qb, kcf) * scale
        s = jnp.concatenate([s_loc.reshape(b, h, N_COLBLK, NA_QBLK, kh * NA_KBLK), s_ctx], axis=-1)
        p = jax.nn.softmax(s, axis=-1)
        p_loc = p[..., :kh * NA_KBLK].reshape(b, h, N_COLBLK, NA_QBLK, kh, NA_KBLK)
        p_ctx = p[..., kh * NA_KBLK:]
        o = jnp.einsum('bhnqik,binkhd->bnqhd', p_loc, vr) + jnp.einsum('bhnqc,bchd->bnqhd', p_ctx, vcf)
        return o.reshape(b, GRID_W, h, d)

    out = lax.map(one_row, jnp.arange(rows, dtype=jnp.int32))
    return jnp.transpose(out, (1, 0, 2, 3, 4)).reshape(b, l, h, d)


def context_attention(q, k, v):
    s = jnp.einsum('bqhd,bkhd->bhqk', q.astype(jnp.float32), k.astype(jnp.float32)) * HEAD_DIM ** -0.5
    p = jax.nn.softmax(s, axis=-1)
    return jnp.einsum('bhqk,bkhd->bqhd', p, v.astype(jnp.float32))


def na_group(pl, pc, rpb, need_ctx):
    ql, kl, vl = [split_heads(t, H_NA) for t in jnp.split(pl, 3, axis=-1)]
    qc, kc, vc = [split_heads(t, H_NA) for t in jnp.split(pc, 3, axis=-1)]
    out_l = merge_heads(neighbourhood_attention(ql, kl, vl, kc, vc, rpb)).astype(pl.dtype)
    out_c = merge_heads(context_attention(qc, kc, vc)).astype(pc.dtype) if need_ctx else None
    return out_l, out_c


def token_mixer(hl, hc, w_in, w_out, conv_w, ret_decay, gdn_a_log, gdn_dt_bias, gdn_norm_g, na_rpb,
                cos, sin, need_ctx):
    pl = hl @ w_in
    pc = hc @ w_in
    c1, c2 = RET_COLS, RET_COLS + GDN_COLS
    r_l, r_c = retention_group(pl[..., :c1], pc[..., :c1], ret_decay, cos, sin, need_ctx)
    g_l, g_c = gdn_group(pl[..., c1:c2], pc[..., c1:c2], conv_w, gdn_a_log, gdn_dt_bias, gdn_norm_g, need_ctx)
    n_l, n_c = na_group(pl[..., c2:], pc[..., c2:], na_rpb, need_ctx)
    yl = jnp.concatenate([r_l, g_l, n_l], axis=-1) @ w_out
    yc = jnp.concatenate([r_c, g_c, n_c], axis=-1) @ w_out if need_ctx else None
    return yl, yc


def swiglu(h, w1, w3, w2):
    return (jax.nn.silu(h @ w1) * (h @ w3)) @ w2


def moe_swiglu(h, w_router, w1, w3, w2):
    b, l, d = h.shape
    n_tok = b * l
    hf = h.reshape(n_tok, d)
    logits = jnp.dot(hf, w_router).astype(jnp.float32)
    top_logit, top_e = lax.top_k(logits, TOP_K)
    gates = jax.nn.softmax(top_logit, axis=-1).astype(h.dtype)
    e_flat = top_e.reshape(-1).astype(jnp.int32)
    tok_flat = jnp.repeat(jnp.arange(n_tok, dtype=jnp.int32), TOP_K)
    w_flat = gates.reshape(-1)
    order = jnp.argsort(e_flat)
    e_sorted, tok_sorted, w_sorted = e_flat[order], tok_flat[order], w_flat[order]
    counts = jax.ops.segment_sum(jnp.ones_like(e_flat), e_flat, num_segments=N_EXPERTS)
    starts = jnp.cumsum(counts) - counts
    padded = (counts + MOE_BLOCK - 1) // MOE_BLOCK * MOE_BLOCK
    pad_ends = jnp.cumsum(padded)
    pad_starts = pad_ends - padded
    dest = pad_starts[e_sorted] + (jnp.arange(n_tok * TOP_K, dtype=jnp.int32) - starts[e_sorted])
    n_blocks = (n_tok * TOP_K + MOE_BLOCK - 1) // MOE_BLOCK + N_EXPERTS
    n_rows = n_blocks * MOE_BLOCK
    buf_tok = jnp.zeros((n_rows,), jnp.int32).at[dest].set(tok_sorted)
    buf_w = jnp.zeros((n_rows,), h.dtype).at[dest].set(w_sorted)
    block_start = jnp.arange(n_blocks, dtype=jnp.int32) * MOE_BLOCK
    block_e = jnp.minimum(jnp.searchsorted(pad_ends, block_start, side='right'), N_EXPERTS - 1)

    def expert_block(args):
        idx, e, wt = args
        return swiglu(hf[idx], w1[e], w3[e], w2[e]) * wt[:, None]

    y = lax.map(expert_block, (buf_tok.reshape(n_blocks, MOE_BLOCK), block_e, buf_w.reshape(n_blocks, MOE_BLOCK)))
    out = jnp.zeros_like(hf).at[buf_tok].add(y.reshape(n_rows, d))
    return out.reshape(b, l, d)


def setup_inputs(seed: int = 0) -> dict:
    key = jax.random.key(seed)
    ks = jax.random.split(key, 24)
    f32 = jnp.float32
    n_dense = (DEPTH + 1) // 2
    n_moe = DEPTH // 2

    def nrm(k, shape, scale):
        return jax.random.normal(k, shape, f32) * scale

    dt = jnp.exp(jax.random.uniform(ks[13], (DEPTH, 2, H_GDN), f32, math.log(1e-3), math.log(1e-1)))
    return {
        'x': nrm(ks[0], (BATCH, SEQ, D_MODEL), 1.0),
        'c': nrm(ks[1], (BATCH, D_MODEL), 1.0),
        'ctx': nrm(ks[2], (BATCH, CTX_LEN, D_MODEL), 1.0),
        'c_ctx': nrm(ks[3], (D_MODEL,), 1.0),
        'ada_w': nrm(ks[4], (DEPTH, D_MODEL, 6 * D_MODEL), 0.5 * D_MODEL ** -0.5),
        'ada_b': nrm(ks[5], (DEPTH, 6 * D_MODEL), 0.02),
        'norm1_g': 1.0 + nrm(ks[6], (DEPTH, D_MODEL), 0.05),
        'norm2_g': 1.0 + nrm(ks[7], (DEPTH, D_MODEL), 0.05),
        'w_in': nrm(ks[8], (DEPTH, D_MODEL, D_IN), D_MODEL ** -0.5),
        'w_out': nrm(ks[9], (DEPTH, D_MIX, D_MODEL), D_MIX ** -0.5),
        'conv_w': nrm(ks[10], (DEPTH, SHORT_CONV, 3 * D_GDN), SHORT_CONV ** -0.5),
        'ret_decay': 5.0 + jnp.arange(H_RET, dtype=f32) + nrm(ks[11], (DEPTH, 2, H_RET), 0.1),
        'gdn_a_log': jnp.log(jax.random.uniform(ks[12], (DEPTH, 2, H_GDN), f32, 1.0, 16.0)),
        'gdn_dt_bias': dt + jnp.log(-jnp.expm1(-dt)),
        'gdn_norm_g': 1.0 + nrm(ks[14], (DEPTH, HEAD_DIM), 0.05),
        'na_rpb': nrm(ks[15], (DEPTH, H_NA, 2 * NA_KH - 1, 2 * NA_KW - 1), 0.1),
        'ffn_w1': nrm(ks[16], (n_dense, D_MODEL, D_FF), D_MODEL ** -0.5),
        'ffn_w3': nrm(ks[17], (n_dense, D_MODEL, D_FF), D_MODEL ** -0.5),
        'ffn_w2': nrm(ks[18], (n_dense, D_FF, D_MODEL), D_FF ** -0.5),
        'moe_router': nrm(ks[19], (n_moe, D_MODEL, N_EXPERTS), D_MODEL ** -0.5),
        'moe_w1': nrm(ks[20], (n_moe, N_EXPERTS, D_MODEL, D_FF), D_MODEL ** -0.5),
        'moe_w3': nrm(ks[21], (n_moe, N_EXPERTS, D_MODEL, D_FF), D_MODEL ** -0.5),
        'moe_w2': nrm(ks[22], (n_moe, N_EXPERTS, D_FF, D_MODEL), D_FF ** -0.5),
        'final_g': 1.0 + nrm(ks[23], (D_MODEL,), 0.05),
    }


def reference(x, c, ctx, c_ctx, ada_w, ada_b, norm1_g, norm2_g, w_in, w_out, conv_w, ret_decay,
              gdn_a_log, gdn_dt_bias, gdn_norm_g, na_rpb, ffn_w1, ffn_w3, ffn_w2,
              moe_router, moe_w1, moe_w3, moe_w2, final_g):
    cos, sin = axial_rope_tables(x.shape[1])
    y = ctx
    sc = jax.nn.silu(c)
    scc = jax.nn.silu(c_ctx)
    for l in range(DEPTH):
        need_ctx = l < DEPTH - 1
        ml = [m[:, None, :] for m in jnp.split(sc @ ada_w[l] + ada_b[l], 6, axis=-1)]
        mc = jnp.split(scc @ ada_w[l] + ada_b[l], 6, axis=-1)
        hl = modulate(rms_norm(x, norm1_g[l]), ml[0], ml[1])
        hc = modulate(rms_norm(y, norm1_g[l]), mc[0], mc[1])
        ol, oc = token_mixer(hl, hc, w_in[l], w_out[l], conv_w[l], ret_decay[l], gdn_a_log[l], gdn_dt_bias[l],
                             gdn_norm_g[l], na_rpb[l], cos, sin, need_ctx)
        x = x + ml[2] * ol
        if need_ctx:
            y = y + mc[2] * oc
        j = l // 2
        if l % 2 == 0:
            ffn = lambda h: swiglu(h, ffn_w1[j], ffn_w3[j], ffn_w2[j])
        else:
            ffn = lambda h: moe_swiglu(h, moe_router[j], moe_w1[j], moe_w3[j], moe_w2[j])
        x = x + ml[5] * ffn(modulate(rms_norm(x, norm2_g[l]), ml[3], ml[4]))
        if need_ctx:
            y = y + mc[5] * ffn(modulate(rms_norm(y, norm2_g[l]), mc[3], mc[4]))
    return rms_norm(x, final_g)
```

```cpp
#include <hip/hip_runtime.h>
#include <cstdio>
#include <cstdint>

#ifndef MK_ONE_LAUNCH
#define MK_ONE_LAUNCH 0
#endif

#define GAS __attribute__((address_space(1)))
#define LAS __attribute__((address_space(3)))
typedef unsigned short bf16;
typedef short bf16x8 __attribute__((ext_vector_type(8)));
typedef float f32x4 __attribute__((ext_vector_type(4)));
typedef float f32x2 __attribute__((ext_vector_type(2)));
typedef unsigned u32x4 __attribute__((ext_vector_type(4)));
typedef unsigned u32x2 __attribute__((ext_vector_type(2)));

constexpr int NB = 8, SEQ = 4096, CTXL = 256, DM = 1024, NLAT = NB * SEQ, NCTX = NB * CTXL, MT = NLAT + NCTX;
constexpr int DFF = 2816, NEXP = 8, NIN = 3840, NINSRC = 3600;
constexpr int NWAVES = 8, NTHR = 512;
constexpr float EPSF = 1e-6f;
constexpr int MOE_CAP_TILES = 132;
constexpr int YROWS = 67584;

constexpr size_t MiB = 1u << 20;
constexpr size_t WS_CTL = 0, CTL_ZERO_BYTES = 1 * MiB;
constexpr size_t WS_MOD = 1 * MiB;
constexpr size_t WS_ROPE = WS_MOD + 2 * 9 * 6144 * 4;
constexpr size_t WS_TOKSLOT = 2 * MiB;
constexpr size_t WS_RINFO = 3 * MiB;
constexpr size_t WS_HM = 4 * MiB;
constexpr size_t SZ_HM = (size_t)MT * DM * 2;
constexpr size_t WS_R = WS_HM + SZ_HM;
constexpr size_t WS_WIN = WS_R;
constexpr size_t WS_WOUT = WS_WIN + (size_t)2 * NIN * DM * 2;
constexpr size_t WS_W13D = WS_WOUT + (size_t)2 * DM * DM * 2;
constexpr size_t WS_W2D = WS_W13D + (size_t)2 * DFF * DM * 2;
constexpr size_t WS_XC = WS_W2D + (size_t)DM * DFF * 2;
constexpr size_t WS_GC = WS_XC + (size_t)NCTX * DM * 4;
constexpr size_t WS_GD = WS_GC + (size_t)64 * 68 * 64 * 4;
constexpr size_t WS_RS = WS_GD + 32768;
constexpr size_t WS_GS = WS_RS + (size_t)32 * 2 * 34 * 4096 * 4;
constexpr size_t WS_GV = WS_GS + (size_t)64 * 68 * 4096 * 2;
constexpr size_t WS_PA = WS_GV + (size_t)64 * 68 * 4096 * 2;
constexpr size_t WS_PB = WS_PA + (size_t)MT * 2048 * 2;
constexpr size_t WS_PC = WS_PB + (size_t)MT * 1536 * 2;
constexpr size_t WS_LAYER_END = WS_PC + (size_t)MT * 256 * 2;
constexpr size_t WS_GW = WS_PB;
constexpr size_t WS_GU = WS_GW + (size_t)64 * 68 * 4096 * 2;
constexpr size_t WS_GK = WS_GU + (size_t)64 * 68 * 4096 * 2;
constexpr size_t WS_ACTD = WS_PA;
constexpr size_t WS_MW13 = WS_HM + (size_t)NLAT * DM * 2;
constexpr size_t WS_MW2 = WS_MW13 + (size_t)NEXP * 2 * DFF * DM * 2;
constexpr size_t WS_ACTM = WS_MW2 + (size_t)NEXP * DM * DFF * 2;
constexpr size_t WS_Y = WS_ACTM + (size_t)MOE_CAP_TILES * 256 * DFF * 2;
constexpr size_t WS_MOE_END = WS_Y + (size_t)YROWS * DM * 2;
constexpr size_t WS_NEED = WS_LAYER_END > WS_MOE_END ? WS_LAYER_END : WS_MOE_END;
static_assert(WS_ACTD + (size_t)MT * DFF * 2 <= WS_PC, "dense ACT overlay");
static_assert(WS_GK + (size_t)64 * 68 * 4096 * 2 <= WS_PC, "GDN W/U/K overlay");
static_assert(WS_NEED <= 542445312ull, "workspace budget");

constexpr int CW_TMO = 0, CW_CNT = 64, CW_BAR = 4096;

constexpr int LDS_BYTES = 147456, MISC_OFF = 147200;

__device__ __forceinline__ float bf2f(bf16 v) { return __uint_as_float((unsigned)v << 16); }
__device__ __forceinline__ unsigned f2bf(float f) { unsigned u = __float_as_uint(f); return (u + 0x7fffu + ((u >> 16) & 1u)) >> 16; }
__device__ __forceinline__ unsigned pk2(float lo, float hi) { return f2bf(lo) | (f2bf(hi) << 16); }
__device__ __forceinline__ float silu_f(float x) { return x / (1.f + __expf(-x)); }
__device__ __forceinline__ float wave_sum(float v) {
#pragma unroll
    for (int o = 1; o < 64; o <<= 1) v += __shfl_xor(v, o);
    return v;
}
__device__ __forceinline__ void load8bf(const bf16* p, float (&o)[8]) {
    const u32x4 w = *(const u32x4*)p;
    o[0] = __uint_as_float(w.x << 16); o[1] = __uint_as_float(w.x & 0xffff0000u);
    o[2] = __uint_as_float(w.y << 16); o[3] = __uint_as_float(w.y & 0xffff0000u);
    o[4] = __uint_as_float(w.z << 16); o[5] = __uint_as_float(w.z & 0xffff0000u);
    o[6] = __uint_as_float(w.w << 16); o[7] = __uint_as_float(w.w & 0xffff0000u);
}
__device__ __forceinline__ void store8bf(bf16* p, const float (&v)[8]) {
    u32x4 w; w.x = pk2(v[0], v[1]); w.y = pk2(v[2], v[3]); w.z = pk2(v[4], v[5]); w.w = pk2(v[6], v[7]);
    *(u32x4*)p = w;
}

#define XB_TMO      128
#define XB_XCNT(j)  (256  + 64 * (j))
#define XB_XSUB(j)  (1280 + 64 * (j))
#define XB_XGEN(j)  (2304 + 64 * (j))
#define XB_TOP      3328
#define XB_TOPGEN   3392
#define XCD_BAR_WORDS 3456
#define XB_SPIN_CAP (1u << 22)
__device__ __forceinline__ unsigned xb_ld(unsigned* p)              { return __hip_atomic_load(p, __ATOMIC_RELAXED, __HIP_MEMORY_SCOPE_AGENT); }
__device__ __forceinline__ unsigned xb_add(unsigned* p, unsigned v) { return __hip_atomic_fetch_add(p, v, __ATOMIC_RELAXED, __HIP_MEMORY_SCOPE_AGENT); }
__device__ __forceinline__ unsigned xb_xcc_id() { return (unsigned)__builtin_amdgcn_s_getreg((3 << 11) | 20) & 0xFu; }
#define XB_SPIN(cond, bar) do { unsigned _sp = 0; while (cond) { __builtin_amdgcn_s_sleep(1); \
    if ((++_sp & 255u) == 0u) { if (xb_ld(&(bar)[XB_TMO])) break; if (_sp > XB_SPIN_CAP) { atomicAdd(&(bar)[XB_TMO], 1u); break; } } } } while (0)
struct XcdBarrier { unsigned* bar; unsigned x; volatile LAS unsigned* st; };
__device__ __forceinline__ XcdBarrier xcd_barrier_post(unsigned* bar, volatile LAS unsigned* st) {
    XcdBarrier b; b.bar = bar; b.x = xb_xcc_id(); b.st = st;
    if (threadIdx.x == 0) (void)xb_add(&bar[XB_XCNT(b.x)], 1u);
    return b;
}
__device__ __forceinline__ void xcd_barrier_complete(unsigned* bar, unsigned x, unsigned& nloc, unsigned& nx) {
    const unsigned G = gridDim.x * gridDim.y * gridDim.z;
    unsigned sum, cnt, mine, sp = 0u;
    for (;;) {
        sum = 0u; cnt = 0u; mine = 0u;
#pragma unroll
        for (unsigned j = 0; j < 16; ++j) { const unsigned c = xb_ld(&bar[XB_XCNT(j)]); sum += c; cnt += (c > 0u) ? 1u : 0u; mine = (j == x) ? c : mine; }
        if (sum == G) break;
        __builtin_amdgcn_s_sleep(1);
        if ((++sp & 255u) == 0u) { if (xb_ld(&bar[XB_TMO])) break; if (sp > XB_SPIN_CAP) { atomicAdd(&bar[XB_TMO], 1u); break; } }
    }
    nloc = mine > 0u ? mine : 1u; nx = cnt > 0u ? cnt : 1u;
}
__device__ __forceinline__ void xcd_barrier(const XcdBarrier& b) {
    asm volatile("s_waitcnt vmcnt(0)" ::: "memory");
    __syncthreads();
    if (threadIdx.x == 0) {
        unsigned* bar = b.bar;
        __builtin_amdgcn_s_waitcnt(0);
        unsigned nloc = b.st[0], nx = b.st[1];
        if (nloc == 0u) { xcd_barrier_complete(bar, b.x, nloc, nx); b.st[0] = nloc; b.st[1] = nx; }
        const unsigned old = xb_add(&bar[XB_XSUB(b.x)], 1u);
        const unsigned gen = old / nloc;
        if (old + 1u == (gen + 1u) * nloc) {
            __builtin_amdgcn_fence(__ATOMIC_RELEASE, "agent");
            asm volatile("s_waitcnt vmcnt(0)" ::: "memory");
            const unsigned og = xb_add(&bar[XB_TOP], 1u);
            const unsigned tg = og / nx;
            if (og + 1u == (tg + 1u) * nx) xb_add(&bar[XB_TOPGEN], 1u);
            else XB_SPIN(xb_ld(&bar[XB_TOPGEN]) == tg, bar);
            __builtin_amdgcn_fence(__ATOMIC_ACQUIRE, "agent");
            xb_add(&bar[XB_XGEN(b.x)], 1u);
            asm volatile("s_waitcnt vmcnt(0)" ::: "memory");
        } else {
            XB_SPIN(xb_ld(&bar[XB_XGEN(b.x)]) == gen, bar);
            __builtin_amdgcn_fence(__ATOMIC_ACQUIRE, "agent");
            asm volatile("s_waitcnt vmcnt(0)" ::: "memory");
        }
    }
    __syncthreads();
}

namespace pg8 {
constexpr int BM = 256, BK = 64, HALF = 128, HTB = HALF * BK * 2, STAGE_BYTES = 8 * HTB, NXCD = 8, WGM = 8;
__host__ __device__ __forceinline__ int lds_byte(int r, int c) { const int st = (r >> 4) * 2 + (c >> 5), rr = r & 15, cc = c & 31, ob = rr * 64 + cc * 2; return st * 1024 + (ob ^ (((ob >> 9) & 1) << 5)); }
__host__ __device__ __forceinline__ void stage_rc(int b, int& R, int& C) { const int st = b / 1024, sb = b % 1024, swz = sb ^ (((sb >> 9) & 1) << 5); R = (st >> 1) * 16 + swz / 64; C = (st & 1) * 32 + (swz % 64) / 2; }
__host__ __device__ __forceinline__ int perm32(int rho) { const int n = rho >> 4, i = rho & 15; return 8 * (i >> 2) + 4 * n + (i & 3); }

struct Unit { int pm, pn, e, T, cnt, pml; };
struct Gemm { const bf16* A; const bf16* Bt; int K; };

__device__ __forceinline__ bool decode_tile(int i, int G, int c, int nM, int nN, int& pm, int& pn) {
    const int nwg = nM * nN; const long L = (long)i * G + c; if (L >= nwg) return false;
    int wgid = (int)L; { const int q = nwg / NXCD, r = nwg % NXCD, xcd = wgid % NXCD, off = wgid / NXCD; wgid = (xcd < r ? xcd * (q + 1) : r * (q + 1) + (xcd - r) * q) + off; }
    const int nig = WGM * nN, gid = wgid / nig, fm = gid * WGM, gsz = (nM - fm) < WGM ? (nM - fm) : WGM;
    pm = fm + ((wgid % nig) % gsz); pn = (wgid % nig) / gsz; return true;
}
struct SchedStatic {
    static constexpr bool GATHER = false;
    int nM, nN, G, c;
    __device__ __forceinline__ bool next(int i, Unit& u) const { u.e = 0; u.T = 0; u.cnt = 0; u.pml = 0; return decode_tile(i, G, c, nM, nN, u.pm, u.pn); }
    __device__ __forceinline__ int a_row(const Unit& u, int r) const { return u.pm * BM + r; }
    __device__ __forceinline__ int a_row0(const Unit& u) const { return u.pm * BM; }
    __device__ __forceinline__ int b_row0(const Unit& u) const { return u.pn * BM; }
};
template <bool UP> struct SchedMoe {
    static constexpr bool GATHER = UP;
    int nM, nN, G, c, t0;
    int ts[9], cn[8]; const int* tokslot;
    __device__ __forceinline__ bool next(int i, Unit& u) const {
        if (!decode_tile(i, G, c, nM, nN, u.pm, u.pn)) return false;
        const int T = t0 + u.pm; int e = 0;
#pragma unroll
        for (int k = 1; k < 8; ++k) e += (T >= ts[k]) ? 1 : 0;
        int tse = 0, cne = 0;
#pragma unroll
        for (int k = 0; k < 8; ++k) { tse = (k == e) ? ts[k] : tse; cne = (k == e) ? cn[k] : cne; }
        u.e = e; u.T = T; u.pml = T - tse; u.cnt = cne; return true;
    }
    __device__ __forceinline__ int a_row(const Unit& u, int r) const {
        if (UP) { const int slot = u.pml * BM + r; return slot < u.cnt ? tokslot[u.e * 32768 + slot] : 0; }
        return u.pm * BM + r;
    }
    __device__ __forceinline__ int a_row0(const Unit& u) const { return u.pm * BM; }
    __device__ __forceinline__ int b_row0(const Unit& u) const { return u.e * (UP ? 2 * DFF : DM) + u.pn * BM; }
};

__device__ __forceinline__ unsigned cvt_pk_bf16(float lo, float hi) { unsigned r; asm volatile("v_cvt_pk_bf16_f32 %0, %1, %2" : "=v"(r) : "v"(lo), "v"(hi)); return r; }

struct EpiInProj {
    static constexpr bool PERM = true;
    bf16 *PA, *PB, *PC;
    __device__ __forceinline__ void operator()(const f32x4 (&acc)[2][2][4][2], const Unit& u, int wr, int wc, int fr, int fq) const {
        bf16* base; int ldc, colt;
        if (u.pn < 8) { base = PA; ldc = 2048; colt = u.pn * 256; } else if (u.pn < 14) { base = PB; ldc = 1536; colt = (u.pn - 8) * 256; } else { base = PC; ldc = 256; colt = 0; }
        const int row0 = u.pm * BM + wr * 64 + fr, col0 = colt + wc * 32 + 8 * fq;
#pragma unroll
        for (int ai = 0; ai < 2; ++ai)
#pragma unroll
            for (int m = 0; m < 4; ++m) { bf16* rowp = base + (size_t)(row0 + ai * HALF + m * 16) * ldc + col0;
#pragma unroll
                for (int bj = 0; bj < 2; ++bj) { const f32x4 v0 = acc[ai][bj][m][0], v1 = acc[ai][bj][m][1];
                    u32x4 w; w.x = cvt_pk_bf16(v0[0], v0[1]); w.y = cvt_pk_bf16(v0[2], v0[3]); w.z = cvt_pk_bf16(v1[0], v1[1]); w.w = cvt_pk_bf16(v1[2], v1[3]);
                    *(u32x4*)(rowp + bj * HALF) = w; } }
    }
};
struct EpiPlain {
    static constexpr bool PERM = true;
    bf16* O; int ldc;
    __device__ __forceinline__ void operator()(const f32x4 (&acc)[2][2][4][2], const Unit& u, int wr, int wc, int fr, int fq) const {
        const int row0 = u.T * BM + wr * 64 + fr, col0 = u.pn * 256 + wc * 32 + 8 * fq;
#pragma unroll
        for (int ai = 0; ai < 2; ++ai)
#pragma unroll
            for (int m = 0; m < 4; ++m) { bf16* rowp = O + (size_t)(row0 + ai * HALF + m * 16) * ldc + col0;
#pragma unroll
                for (int bj = 0; bj < 2; ++bj) { const f32x4 v0 = acc[ai][bj][m][0], v1 = acc[ai][bj][m][1];
                    u32x4 w; w.x = cvt_pk_bf16(v0[0], v0[1]); w.y = cvt_pk_bf16(v0[2], v0[3]); w.z = cvt_pk_bf16(v1[0], v1[1]); w.w = cvt_pk_bf16(v1[2], v1[3]);
                    *(u32x4*)(rowp + bj * HALF) = w; } }
    }
};
struct EpiSwiglu {
    static constexpr bool PERM = true;
    bf16* O;
    __device__ __forceinline__ void operator()(const f32x4 (&acc)[2][2][4][2], const Unit& u, int wr, int wc, int fr, int fq) const {
        const int row0 = u.pm * BM + wr * 64 + fr, col0 = u.pn * 128 + wc * 32 + 8 * fq;
#pragma unroll
        for (int ai = 0; ai < 2; ++ai)
#pragma unroll
            for (int m = 0; m < 4; ++m) { bf16* rowp = O + (size_t)(row0 + ai * HALF + m * 16) * DFF + col0;
                float r[8];
#pragma unroll
                for (int n = 0; n < 2; ++n)
#pragma unroll
                    for (int j = 0; j < 4; ++j) { const float a = acc[ai][0][m][n][j], b = acc[ai][1][m][n][j]; r[n * 4 + j] = a * b * __builtin_amdgcn_rcpf(1.f + __expf(-a)); }
                u32x4 w; w.x = cvt_pk_bf16(r[0], r[1]); w.y = cvt_pk_bf16(r[2], r[3]); w.z = cvt_pk_bf16(r[4], r[5]); w.w = cvt_pk_bf16(r[6], r[7]);
                *(u32x4*)rowp = w; }
    }
};
struct EpiResGate {
    static constexpr bool PERM = false;
    const float* resL; const float* resC; float* outL; float* outC; const float* gate;
    __device__ __forceinline__ void operator()(const f32x4 (&acc)[2][2][4][2], const Unit& u, int wr, int wc, int fr, int fq) const {
        const int trow = u.pm * BM; const bool lat = trow < NLAT;
        const float* res = lat ? resL + (size_t)trow * DM : resC + (size_t)(trow - NLAT) * DM;
        float* out = lat ? outL + (size_t)trow * DM : outC + (size_t)(trow - NLAT) * DM;
        const float* g = gate + (size_t)(lat ? (trow >> 12) : 8) * 6144;
        const int col0 = u.pn * BM + wc * 32 + 4 * fq;
#pragma unroll
        for (int bj = 0; bj < 2; ++bj)
#pragma unroll
            for (int n = 0; n < 2; ++n) { const f32x4 gv = *(const f32x4*)(g + col0 + bj * HALF + n * 16);
#pragma unroll
                for (int ai = 0; ai < 2; ++ai)
#pragma unroll
                    for (int m = 0; m < 4; ++m) { const size_t ro = (size_t)(wr * 64 + fr + ai * HALF + m * 16) * DM + col0 + bj * HALF + n * 16;
                        const f32x4 rv = *(const f32x4*)(res + ro);
                        *(f32x4*)(out + ro) = rv + gv * acc[ai][bj][m][n]; } }
    }
};

template <class Epi, class Sched>
__device__ __forceinline__ void gemm_phase(LAS unsigned char* lds, const Gemm g, const Sched& S, const Epi& E, const int tid) {
    const int wid = __builtin_amdgcn_readfirstlane(tid >> 6), lane = tid & 63, wr = wid >> 2, wc = wid & 3, fr = lane & 15, fq = lane >> 4;
    const int K = g.K, nt = K / BK;
    constexpr bool GATHER = Sched::GATHER;
    int RA[2], CA[2]; unsigned voffB[2], voffA[2];
#pragma unroll
    for (int i = 0; i < 2; ++i) { int R, C; stage_rc(tid * 16 + i * 8192, R, C); const int Rb = Epi::PERM ? ((R & ~31) + perm32(R & 31)) : R;
        RA[i] = R; CA[i] = C * 2; voffB[i] = (unsigned)(Rb * K + C) * 2u; voffA[i] = (unsigned)(R * K + C) * 2u; }
    const size_t kstep = (size_t)(BK * 2);
    const size_t hstep = (size_t)HALF * K * 2;
    const unsigned rowb = (unsigned)K * 2u;
    const unsigned ldsw = (unsigned)wid * 1024u;
    const int aoff = lds_byte(wr * 64 + fr, fq * 8), boff = lds_byte(wc * 32 + fr, fq * 8);
#define PG8_SA(b, h) (((b) * 2 + (h)) * HTB)
#define PG8_SB(b, h) ((4 + (b) * 2 + (h)) * HTB)
#define PG8_STAGE(bufoff, gbase, voff) do { _Pragma("unroll") for (int _i = 0; _i < 2; ++_i) \
        __builtin_amdgcn_global_load_lds((const unsigned*)((const char*)(gbase) + (voff)[_i]), (LAS unsigned*)(lds + (bufoff) + ldsw + _i * 8192), 16, 0, 0); } while (0)
#define PG8_LDA(dst, b, h) do { _Pragma("unroll") for (int m = 0; m < 4; ++m) _Pragma("unroll") for (int k = 0; k < 2; ++k) dst[m][k] = *(const LAS bf16x8*)(lds + PG8_SA(b, h) + aoff + m * 2048 + k * 1024); } while (0)
#define PG8_LDB(dst, b, h) do { _Pragma("unroll") for (int n = 0; n < 2; ++n) _Pragma("unroll") for (int k = 0; k < 2; ++k) dst[n][k] = *(const LAS bf16x8*)(lds + PG8_SB(b, h) + boff + n * 2048 + k * 1024); } while (0)
#define PG8_MMA(ai, bj, At, Bt) do { __builtin_amdgcn_s_setprio(1); _Pragma("unroll") for (int m = 0; m < 4; ++m) _Pragma("unroll") for (int n = 0; n < 2; ++n) _Pragma("unroll") for (int k = 0; k < 2; ++k) \
        acc[ai][bj][m][n] = __builtin_amdgcn_mfma_f32_16x16x32_bf16(Bt[n][k], At[m][k], acc[ai][bj][m][n], 0, 0, 0); __builtin_amdgcn_s_setprio(0); } while (0)
#define PG8_WAIT_V(n) asm volatile("s_waitcnt vmcnt(" #n ")" ::: "memory")
#define PG8_WAIT_L(n) asm volatile("s_waitcnt lgkmcnt(" #n ")" ::: "memory")
#define PG8_BAR __builtin_amdgcn_s_barrier()
#define PG8_SCHED __builtin_amdgcn_sched_barrier(0)
#define PG8_STA_CUR(bufoff, ptr, hh) do { if constexpr (GATHER) PG8_STAGE(bufoff, ptr, vAc[hh]); else PG8_STAGE(bufoff, (ptr) + (hh) * hstep, voffA); } while (0)
#define PG8_STA_SEL(bufoff, ptr, hh) do { if constexpr (GATHER) PG8_STAGE(bufoff, ptr, vs[hh]); else PG8_STAGE(bufoff, (ptr) + (hh) * hstep, voffA); } while (0)
#define PG8_MKVOFF(dst, uu) do { _Pragma("unroll") for (int _h = 0; _h < 2; ++_h) _Pragma("unroll") for (int _i = 0; _i < 2; ++_i) \
        dst[_h][_i] = (unsigned)S.a_row(uu, _h * HALF + RA[_i]) * rowb + (unsigned)CA[_i]; } while (0)
    Unit cur, nxt; int ui = 0;
    if (!S.next(0, cur)) return;
    f32x4 acc[2][2][4][2];
#pragma unroll
    for (int a = 0; a < 2; ++a)
#pragma unroll
        for (int b = 0; b < 2; ++b)
#pragma unroll
            for (int m = 0; m < 4; ++m)
#pragma unroll
                for (int n = 0; n < 2; ++n) acc[a][b][m][n] = (f32x4){0.f, 0.f, 0.f, 0.f};
    bf16x8 At[4][2], B0[2][2], B1[2][2];
    unsigned vAc[2][2], vAn[2][2], vs[2][2];
    if constexpr (GATHER) PG8_MKVOFF(vAc, cur);
    const char* cA = (const char*)g.A + (GATHER ? (size_t)0 : (size_t)S.a_row0(cur) * rowb);
    const char* cB = (const char*)g.Bt + (size_t)S.b_row0(cur) * rowb;
    PG8_STAGE(PG8_SB(0, 0), cB, voffB); PG8_STAGE(PG8_SB(0, 1), cB + hstep, voffB); PG8_STA_CUR(PG8_SA(0, 0), cA, 0); PG8_STA_CUR(PG8_SA(0, 1), cA, 1);
    if (wr == 1) PG8_BAR;
    PG8_WAIT_V(2); PG8_BAR;
    PG8_STAGE(PG8_SB(1, 0), cB + kstep, voffB); PG8_STA_CUR(PG8_SA(1, 0), cA + kstep, 0); PG8_STAGE(PG8_SB(1, 1), cB + hstep + kstep, voffB);
    PG8_WAIT_V(6); PG8_BAR;
    for (;;) {
        const bool has_next = S.next(ui + 1, nxt);
        const char* nB = cB; const char* nA = cA;
        if (has_next) { if constexpr (GATHER) PG8_MKVOFF(vAn, nxt); else nA = (const char*)g.A + (size_t)S.a_row0(nxt) * rowb; nB = (const char*)g.Bt + (size_t)S.b_row0(nxt) * rowb; }
        else if constexpr (GATHER) {
#pragma unroll
            for (int h = 0; h < 2; ++h)
#pragma unroll
                for (int i = 0; i < 2; ++i) vAn[h][i] = vAc[h][i];
        }
        for (int t = 0; t < nt; t += 2) {
            const bool last = (t == nt - 2);
            const char* a1 = cA + (size_t)(t + 1) * kstep;
            const char* a2 = last ? nA : cA + (size_t)(t + 2) * kstep; const char* b2 = last ? nB : cB + (size_t)(t + 2) * kstep;
            const char* a3 = a2 + kstep; const char* b3 = b2 + kstep;
            if constexpr (GATHER) {
#pragma unroll
                for (int h = 0; h < 2; ++h)
#pragma unroll
                    for (int i = 0; i < 2; ++i) vs[h][i] = last ? vAn[h][i] : vAc[h][i];
            }
            PG8_LDB(B0, 0, 0); PG8_LDB(B1, 0, 1); PG8_SCHED; PG8_LDA(At, 0, 0); PG8_STA_CUR(PG8_SA(1, 1), a1, 1);
            PG8_WAIT_V(8); PG8_WAIT_L(0); PG8_BAR; PG8_MMA(0, 0, At, B0); PG8_MMA(0, 1, At, B1); PG8_BAR; PG8_SCHED;
            PG8_LDA(At, 0, 1); PG8_STAGE(PG8_SB(0, 0), b2, voffB); PG8_STAGE(PG8_SB(0, 1), b2 + hstep, voffB); PG8_STA_SEL(PG8_SA(0, 0), a2, 0);
            PG8_WAIT_V(8); PG8_WAIT_L(0); PG8_BAR; PG8_MMA(1, 0, At, B0); PG8_MMA(1, 1, At, B1); PG8_BAR; PG8_SCHED;
            PG8_LDB(B0, 1, 0); PG8_LDB(B1, 1, 1); PG8_SCHED; PG8_LDA(At, 1, 0); PG8_STA_SEL(PG8_SA(0, 1), a2, 1);
            PG8_WAIT_V(8); PG8_WAIT_L(0); PG8_BAR; PG8_MMA(0, 0, At, B0); PG8_MMA(0, 1, At, B1); PG8_BAR; PG8_SCHED;
            PG8_LDA(At, 1, 1); PG8_STAGE(PG8_SB(1, 0), b3, voffB); PG8_STAGE(PG8_SB(1, 1), b3 + hstep, voffB); PG8_STA_SEL(PG8_SA(1, 0), a3, 0);
            PG8_WAIT_V(8); PG8_WAIT_L(0); PG8_BAR; PG8_MMA(1, 0, At, B0); PG8_MMA(1, 1, At, B1); PG8_BAR; PG8_SCHED;
        }
        if (wr == 0) PG8_BAR;
        E(acc, cur, wr, wc, fr, fq);
        if (!has_next) break;
#pragma unroll
        for (int a = 0; a < 2; ++a)
#pragma unroll
            for (int b = 0; b < 2; ++b)
#pragma unroll
                for (int m = 0; m < 4; ++m)
#pragma unroll
                    for (int n = 0; n < 2; ++n) acc[a][b][m][n] = (f32x4){0.f, 0.f, 0.f, 0.f};
        cur = nxt; cB = nB; cA = nA; ++ui;
        if constexpr (GATHER) {
#pragma unroll
            for (int h = 0; h < 2; ++h)
#pragma unroll
                for (int i = 0; i < 2; ++i) vAc[h][i] = vAn[h][i];
        }
        if (wr == 1) PG8_BAR;
    }
    PG8_WAIT_V(0);
    PG8_BAR;
#undef PG8_SA
#undef PG8_SB
#undef PG8_STAGE
#undef PG8_LDA
#undef PG8_LDB
#undef PG8_MMA
#undef PG8_WAIT_V
#undef PG8_WAIT_L
#undef PG8_BAR
#undef PG8_SCHED
#undef PG8_MKVOFF
#undef PG8_STA_CUR
#undef PG8_STA_SEL
}
}

struct Frame {
    LAS unsigned char* lds;
    int tid, lane, wave, G, bid;
    const float* const __attribute__((address_space(4)))* in;
    float* out; unsigned char* ws;
};
#define IN_X 0
#define IN_C 1
#define IN_CTX 2
#define IN_CCTX 3
#define IN_ADAW 4
#define IN_ADAB 5
#define IN_N1G 6
#define IN_N2G 7
#define IN_WIN 8
#define IN_WOUT 9
#define IN_CONVW 10
#define IN_RETDEC 11
#define IN_ALOG 12
#define IN_DTB 13
#define IN_GNG 14
#define IN_RPB 15
#define IN_FW1 16
#define IN_FW3 17
#define IN_FW2 18
#define IN_ROUTER 19
#define IN_MW1 20
#define IN_MW3 21
#define IN_MW2 22
#define IN_FINALG 23

__device__ __forceinline__ const float* mod_vec(const Frame& F, int l, int row, int slot) {
    const int j = row < NLAT ? (row >> 12) : 8;
    return (const float*)(F.ws + WS_MOD) + ((size_t)(l * 9 + j) * 6 + slot) * 1024;
}

__device__ __forceinline__ int dst_row(int kind, int n) {
    if (kind == 1) return n < 2048 ? n : (n < 2064 ? 3584 + (n - 2048) : n - 16);
    if (kind == 2) return 256 * (n >> 7) + (n & 127);
    if (kind == 3) return 256 * (n >> 7) + 128 + (n & 127);
    return n;
}
__device__ __forceinline__ void transpose_item(const float* W, int K, int N, bf16* WT, int kind, LAS float* scr, int item, int lane) {
    const int nblk = (N + 31) / 32, kb = item / nblk, nb = item % nblk, k0 = 64 * kb, n0 = 32 * nb;
    const bool nok = (n0 + (lane & 31)) < N;
#pragma unroll 8
    for (int i = 0; i < 32; ++i) { const int kk = 2 * i + (lane >> 5); scr[kk * 33 + (lane & 31)] = nok ? W[(size_t)(k0 + kk) * N + n0 + (lane & 31)] : 0.f; }
    asm volatile("s_waitcnt lgkmcnt(0)" ::: "memory");
    const int c = lane & 7;
#pragma unroll
    for (int j = 0; j < 4; ++j) { const int n = (lane >> 3) + 8 * j; const LAS float* s = scr + (8 * c) * 33 + n;
        u32x4 o; o.x = pk2(s[0 * 33], s[1 * 33]); o.y = pk2(s[2 * 33], s[3 * 33]); o.z = pk2(s[4 * 33], s[5 * 33]); o.w = pk2(s[6 * 33], s[7 * 33]);
        if (n0 + n < N) *(u32x4*)(WT + (size_t)dst_row(kind, n0 + n) * K + k0 + 8 * c) = o; }
    asm volatile("s_waitcnt lgkmcnt(0)" ::: "memory");
}

__device__ __forceinline__ void sincos_d(double x, float& c, float& s) {
    const double n = rint(x * 0.63661977236758134308), r = (x - n * 1.57079632679489655800) - n * 6.123233995736766036e-17;
    const double r2 = r * r;
    double sp = r * (1.0 + r2 * (-1.0 / 6 + r2 * (1.0 / 120 + r2 * (-1.0 / 5040 + r2 * (1.0 / 362880 + r2 * (-1.0 / 39916800 + r2 * (1.0 / 6227020800.0)))))));
    double cp = 1.0 + r2 * (-0.5 + r2 * (1.0 / 24 + r2 * (-1.0 / 720 + r2 * (1.0 / 40320 + r2 * (-1.0 / 3628800 + r2 * (1.0 / 479001600.0 + r2 * (-1.0 / 87178291200.0)))))));
    const int q = ((int)n) & 3;
    const double ss = (q == 0) ? sp : (q == 1) ? cp : (q == 2) ? -sp : -cp;
    const double cc = (q == 0) ? cp : (q == 1) ? -sp : (q == 2) ? -cp : sp;
    c = (float)cc; s = (float)ss;
}

__device__ __forceinline__ void phase_prologue(Frame& F) {
    for (int it = F.bid; it < 192; it += F.G) {
        const int l = it / 96, cb = it % 96, n = cb * 64 + F.lane;
        LAS float* SV = (LAS float*)F.lds;
        LAS float* RED = SV + 9 * 1024;
        for (int i = F.tid; i < 9 * 1024; i += NTHR) { const int j = i >> 10, k = i & 1023; const float v = j < 8 ? F.in[IN_C][j * 1024 + k] : F.in[IN_CCTX][k]; SV[i] = silu_f(v); }
        __syncthreads();
        float a[9];
#pragma unroll
        for (int j = 0; j < 9; ++j) a[j] = 0.f;
        const float* W = F.in[IN_ADAW] + (size_t)l * 1024 * 6144 + n;
        const int k0 = F.wave * 128;
#pragma unroll 8
        for (int k = 0; k < 128; ++k) { const float w = W[(size_t)(k0 + k) * 6144];
#pragma unroll
            for (int j = 0; j < 9; ++j) a[j] += w * SV[j * 1024 + k0 + k]; }
#pragma unroll
        for (int j = 0; j < 9; ++j) RED[(F.wave * 9 + j) * 64 + F.lane] = a[j];
        __syncthreads();
        for (int i = F.tid; i < 9 * 64; i += NTHR) { const int j = i >> 6, c = i & 63; float s = F.in[IN_ADAB][l * 6144 + cb * 64 + c];
#pragma unroll
            for (int w = 0; w < 8; ++w) s += RED[(w * 9 + j) * 64 + c];
            ((float*)(F.ws + WS_MOD))[(size_t)(l * 9 + j) * 6144 + cb * 64 + c] = s; }
        __syncthreads();
    }
    if (F.bid == F.G - 1) {
        for (int i = F.tid; i < 1024; i += NTHR) { const int pos = i >> 4, f = i & 15;
            const float invf = (float)exp2(-(double)f / 16.0 * 13.287712379549449);
            float c, s; sincos_d((double)((float)pos * invf), c, s);
            ((f32x2*)(F.ws + WS_ROPE))[i] = (f32x2){c, s}; }
    }
    LAS float* scr = (LAS float*)(F.lds + F.wave * 8448);
    __syncthreads();
    const int gw = F.bid * NWAVES + F.wave, NGW = F.G * NWAVES;
    constexpr int I_IN = 16 * 113, I_OUT = 16 * 32, I_FF = 16 * 88, I_F2 = 44 * 32;
    constexpr int NIT = 2 * I_IN + 2 * I_OUT + 2 * I_FF + I_F2;
    for (int it = gw; it < NIT; it += NGW) {
        int r = it;
        if (r < 2 * I_IN) { const int l = r / I_IN; transpose_item(F.in[IN_WIN] + (size_t)l * DM * NINSRC, DM, NINSRC, (bf16*)(F.ws + WS_WIN) + (size_t)l * NIN * DM, 1, scr, r % I_IN, F.lane); continue; } r -= 2 * I_IN;
        if (r < 2 * I_OUT) { const int l = r / I_OUT; transpose_item(F.in[IN_WOUT] + (size_t)l * DM * DM, DM, DM, (bf16*)(F.ws + WS_WOUT) + (size_t)l * DM * DM, 0, scr, r % I_OUT, F.lane); continue; } r -= 2 * I_OUT;
        if (r < I_FF) { transpose_item(F.in[IN_FW1], DM, DFF, (bf16*)(F.ws + WS_W13D), 2, scr, r, F.lane); continue; } r -= I_FF;
        if (r < I_FF) { transpose_item(F.in[IN_FW3], DM, DFF, (bf16*)(F.ws + WS_W13D), 3, scr, r, F.lane); continue; } r -= I_FF;
        transpose_item(F.in[IN_FW2], DFF, DM, (bf16*)(F.ws + WS_W2D), 0, scr, r, F.lane);
    }
    for (int i = F.bid * NTHR + F.tid; i < 2 * 240 * 128; i += F.G * NTHR) { const int l = i / (240 * 128), r = (i / 128) % 240, c = i % 128;
        *(u32x4*)((bf16*)(F.ws + WS_WIN) + ((size_t)l * NIN + 3600 + r) * DM + c * 8) = (u32x4){0u, 0u, 0u, 0u}; }
}
__device__ __forceinline__ void moe_weight_copy(Frame& F) {
    LAS float* scr = (LAS float*)(F.lds + F.wave * 8448);
    const int gw = F.bid * NWAVES + F.wave, NGW = F.G * NWAVES;
    constexpr int I_FF = 16 * 88, I_F2 = 44 * 32, PER_E = 2 * I_FF + I_F2;
    for (int it = gw; it < NEXP * PER_E; it += NGW) {
        const int e = it / PER_E; int r = it % PER_E;
        bf16* w13 = (bf16*)(F.ws + WS_MW13) + (size_t)e * 2 * DFF * DM; bf16* w2 = (bf16*)(F.ws + WS_MW2) + (size_t)e * DM * DFF;
        const size_t eo = (size_t)e * DM * DFF;
        if (r < I_FF) { transpose_item(F.in[IN_MW1] + eo, DM, DFF, w13, 2, scr, r, F.lane); continue; } r -= I_FF;
        if (r < I_FF) { transpose_item(F.in[IN_MW3] + eo, DM, DFF, w13, 3, scr, r, F.lane); continue; } r -= I_FF;
        transpose_item(F.in[IN_MW2] + eo, DFF, DM, w2, 0, scr, r, F.lane);
    }
}

__device__ __forceinline__ void norm_row(const Frame& F, const float* xrow, const float* g, const float* shift, const float* scale, bf16* orow, f32x4 (&hv)[4]) {
    const f32x4* xr = (const f32x4*)xrow + F.lane;
    f32x4 v[4]; float s = 0.f;
#pragma unroll
    for (int j = 0; j < 4; ++j) { v[j] = xr[64 * j]; s += (v[j].x * v[j].x + v[j].y * v[j].y) + (v[j].z * v[j].z + v[j].w * v[j].w); }
    const float rstd = 1.0f / sqrtf(wave_sum(s) * (1.f / DM) + EPSF);
#pragma unroll
    for (int j = 0; j < 4; ++j) {
        const f32x4 gg = ((const f32x4*)g)[F.lane + 64 * j], sh = ((const f32x4*)shift)[F.lane + 64 * j], sc = ((const f32x4*)scale)[F.lane + 64 * j];
        hv[j] = (v[j] * rstd * gg) * (sc + 1.0f) + sh;
        u32x2 o; o.x = pk2(hv[j].x, hv[j].y); o.y = pk2(hv[j].z, hv[j].w);
        *((u32x2*)orow + F.lane + 64 * j) = o;
    }
}
__device__ __forceinline__ void phase_norm(Frame& F, int l, int which  , const float* xl, const float* xc, int nrows) {
    const float* g = F.in[which ? IN_N2G : IN_N1G] + l * 1024;
    const int gw = F.bid * NWAVES + F.wave, NGW = F.G * NWAVES;
    for (int row = gw; row < nrows; row += NGW) {
        const float* xrow = row < NLAT ? xl + (size_t)row * DM : xc + (size_t)(row - NLAT) * DM;
        f32x4 hv[4];
        norm_row(F, xrow, g, mod_vec(F, l, row, which ? 3 : 0), mod_vec(F, l, row, which ? 4 : 1), (bf16*)(F.ws + WS_HM) + (size_t)row * DM, hv);
    }
}
__device__ __forceinline__ void phase_norm_route(Frame& F, int l, const float* xl) {
    const float* g = F.in[IN_N2G] + l * 1024;
    LAS float* WR = (LAS float*)F.lds;
    LAS int* RE = (LAS int*)(F.lds + 32768);
    LAS float* RG = (LAS float*)(F.lds + 32768 + 1024);
    LAS int* LC = (LAS int*)(F.lds + 32768 + 2048);
    LAS int* RK = (LAS int*)(F.lds + 32768 + 2048 + 64);
    for (int i = F.tid; i < 8192; i += NTHR) WR[i] = F.in[IN_ROUTER][i];
    unsigned* gcnt = (unsigned*)(F.ws + WS_CTL) + CW_CNT;
    int* tokslot = (int*)(F.ws + WS_TOKSLOT);
    for (int blk = F.bid; blk < NLAT / 128; blk += F.G) {
        if (F.tid < 16) LC[F.tid] = 0;
        __syncthreads();
        for (int rr = 0; rr < 16; ++rr) {
            const int lr = F.wave * 16 + rr, row = blk * 128 + lr;
            f32x4 hv[4];
            norm_row(F, xl + (size_t)row * DM, g, mod_vec(F, l, row, 3), mod_vec(F, l, row, 4), (bf16*)(F.ws + WS_HM) + (size_t)row * DM, hv);
            float lg[8];
#pragma unroll
            for (int e = 0; e < 8; ++e) lg[e] = 0.f;
#pragma unroll
            for (int j = 0; j < 4; ++j)
#pragma unroll
                for (int c = 0; c < 4; ++c) { const int k = 4 * (F.lane + 64 * j) + c; const float hval = hv[j][c];
                    const f32x4 w0 = *(const LAS f32x4*)(WR + k * 8), w1 = *(const LAS f32x4*)(WR + k * 8 + 4);
                    lg[0] += hval * w0.x; lg[1] += hval * w0.y; lg[2] += hval * w0.z; lg[3] += hval * w0.w;
                    lg[4] += hval * w1.x; lg[5] += hval * w1.y; lg[6] += hval * w1.z; lg[7] += hval * w1.w; }
#pragma unroll
            for (int e = 0; e < 8; ++e) lg[e] = wave_sum(lg[e]);
            if (F.lane == 0) {
                int e0 = 0; float v0 = lg[0];
#pragma unroll
                for (int e = 1; e < 8; ++e) if (lg[e] > v0) { v0 = lg[e]; e0 = e; }
                int e1 = -1; float v1 = -3.0e38f;
#pragma unroll
                for (int e = 0; e < 8; ++e) if (e != e0 && lg[e] > v1) { v1 = lg[e]; e1 = e; }
                const float g1 = 1.f / (1.f + __expf(v0 - v1)), g0 = 1.f - g1;
                RE[lr * 2] = e0; RE[lr * 2 + 1] = e1; RG[lr * 2] = g0; RG[lr * 2 + 1] = g1;
            }
        }
        __syncthreads();
        if (F.tid < 256) { const int e = RE[F.tid]; RK[F.tid] = atomicAdd((int*)&LC[e], 1); }
        __syncthreads();
        if (F.tid < 8) LC[8 + F.tid] = (int)__hip_atomic_fetch_add(gcnt + F.tid, (unsigned)LC[F.tid], __ATOMIC_RELAXED, __HIP_MEMORY_SCOPE_AGENT);
        __syncthreads();
        if (F.tid < 128) {
            const int row = blk * 128 + F.tid;
            const int e0 = RE[F.tid * 2], e1 = RE[F.tid * 2 + 1];
            const int p0 = LC[8 + e0] + RK[F.tid * 2], p1 = LC[8 + e1] + RK[F.tid * 2 + 1];
            tokslot[e0 * 32768 + p0] = row; tokslot[e1 * 32768 + p1] = row;
            u32x4 a; a.x = (unsigned)e0; a.y = (unsigned)p0; a.z = (unsigned)e1; a.w = (unsigned)p1;
            u32x4 b; b.x = __float_as_uint(RG[F.tid * 2]); b.y = __float_as_uint(RG[F.tid * 2 + 1]); b.z = 0u; b.w = 0u;
            u32x4* ri = (u32x4*)(F.ws + WS_RINFO) + (size_t)row * 2; ri[0] = a; ri[1] = b;
        }
        __syncthreads();
    }
}

__device__ __forceinline__ void phase_final(Frame& F) {
    const unsigned* gcnt = (const unsigned*)(F.ws + WS_CTL) + CW_CNT;
    int ts[8]; { int acc = 0;
#pragma unroll
        for (int e = 0; e < 8; ++e) { ts[e] = acc; acc += ((int)gcnt[e] + 255) >> 8; } }
    const bf16* Y = (const bf16*)(F.ws + WS_Y);
    const int gw = F.bid * NWAVES + F.wave, NGW = F.G * NWAVES;
    for (int row = gw; row < NLAT; row += NGW) {
        const u32x4* ri = (const u32x4*)(F.ws + WS_RINFO) + (size_t)row * 2; const u32x4 a = ri[0], b = ri[1];
        int t0 = 0, t1 = 0;
#pragma unroll
        for (int e = 0; e < 8; ++e) { t0 = ((int)a.x == e) ? ts[e] : t0; t1 = ((int)a.z == e) ? ts[e] : t1; }
        const bf16* y0 = Y + (size_t)(t0 * 256 + (int)a.y) * DM; const bf16* y1 = Y + (size_t)(t1 * 256 + (int)a.w) * DM;
        const float g0 = __uint_as_float(b.x), g1 = __uint_as_float(b.y);
        const float* gate = mod_vec(F, 1, row, 5);
        f32x4* xr = (f32x4*)(F.out + (size_t)row * DM) + F.lane;
        f32x4 v[4]; float s = 0.f;
#pragma unroll
        for (int j = 0; j < 4; ++j) {
            const u32x2 w0 = *((const u32x2*)y0 + F.lane + 64 * j), w1 = *((const u32x2*)y1 + F.lane + 64 * j);
            f32x4 a0, a1;
            a0.x = __uint_as_float(w0.x << 16); a0.y = __uint_as_float(w0.x & 0xffff0000u); a0.z = __uint_as_float(w0.y << 16); a0.w = __uint_as_float(w0.y & 0xffff0000u);
            a1.x = __uint_as_float(w1.x << 16); a1.y = __uint_as_float(w1.x & 0xffff0000u); a1.z = __uint_as_float(w1.y << 16); a1.w = __uint_as_float(w1.y & 0xffff0000u);
            const f32x4 gt = ((const f32x4*)gate)[F.lane + 64 * j];
            v[j] = xr[64 * j] + gt * (a0 * g0 + a1 * g1);
            s += (v[j].x * v[j].x + v[j].y * v[j].y) + (v[j].z * v[j].z + v[j].w * v[j].w);
        }
        const float rstd = 1.0f / sqrtf(wave_sum(s) * (1.f / DM) + EPSF);
#pragma unroll
        for (int j = 0; j < 4; ++j) xr[64 * j] = v[j] * rstd * ((const f32x4*)F.in[IN_FINALG])[F.lane + 64 * j];
    }
}

__device__ __forceinline__ float ret_lg(const Frame& F, int l, int dir, int h) { return log1pf(-exp2f(-F.in[IN_RETDEC][(l * 2 + dir) * 4 + h])); }
__device__ __forceinline__ int ret_row(int b, int c, int j) { return c < 2 ? NLAT + b * CTXL + c * 128 + j : b * SEQ + (c - 2) * 128 + j; }
__device__ __forceinline__ int gdn_row(int b, int c, int j) { return c < 4 ? NLAT + b * CTXL + c * 64 + j : b * SEQ + (c - 4) * 64 + j; }

__device__ __forceinline__ void ret_load(const Frame& F, LAS float* dst, int pitch, int b, int c, int col0, bool rope, float scl) {
    const bf16* PA = (const bf16*)(F.ws + WS_PA); const f32x2* RT = (const f32x2*)(F.ws + WS_ROPE);
    for (int i = F.tid; i < 128 * 32; i += NTHR) { const int j = i >> 5, p = i & 31; const int row = ret_row(b, c, j);
        const float x1 = bf2f(PA[(size_t)row * 2048 + col0 + p]), x2 = bf2f(PA[(size_t)row * 2048 + col0 + 32 + p]);
        float o1 = x1, o2 = x2;
        if (rope && c >= 2) { const int t = (c - 2) * 128 + j; const int pos = p < 16 ? (t >> 6) : (t & 63); const f32x2 cs = RT[pos * 16 + (p & 15)];
            o1 = x1 * cs.x - x2 * cs.y; o2 = x1 * cs.y + x2 * cs.x; }
        dst[j * pitch + p] = o1 * scl; dst[j * pitch + 32 + p] = o2 * scl; }
}
__device__ __forceinline__ void phase_R1(Frame& F, int l) {
    LAS float* kf = (LAS float*)F.lds; LAS float* vf = kf + 128 * 64; LAS float* wt = vf + 128 * 64;
    float* RS = (float*)(F.ws + WS_RS);
    for (int u = F.bid; u < 32 * 34; u += F.G) {
        const int bh = u / 34, c = u % 34, b = bh >> 2, h = bh & 3;
        ret_load(F, kf, 64, b, c, 256 + h * 64, true, 0.125f);
        ret_load(F, vf, 64, b, c, 512 + h * 64, false, 1.f);
        if (F.tid < 256) { const int dir = F.tid >> 7, j = F.tid & 127; wt[F.tid] = __expf(ret_lg(F, l, dir, h) * (float)(dir ? j : 127 - j)); }
        __syncthreads();
#pragma unroll 1
        for (int r = 0; r < 16; ++r) { const int o = F.tid + NTHR * r, dir = o >> 12, dk = (o >> 6) & 63, dv = o & 63;
            float s = 0.f;
            for (int j = 0; j < 128; ++j) s += kf[j * 64 + dk] * wt[dir * 128 + j] * vf[j * 64 + dv];
            RS[(((size_t)bh * 2 + dir) * 34 + c) * 4096 + dk * 64 + dv] = s; }
        __syncthreads();
    }
}
__device__ __forceinline__ void phase_R2(Frame& F, int l) {
    float* RS = (float*)(F.ws + WS_RS);
    for (int it = F.bid; it < 256; it += F.G) {
        const int seq = it >> 2, bh = seq >> 1, dir = seq & 1, h = bh & 3;
        const float cd = __expf(ret_lg(F, l, dir, h) * 128.f);
        f32x2* base = (f32x2*)(RS + (size_t)seq * 34 * 4096) + (it & 3) * 512 + F.tid;
        f32x2 s = (f32x2){0.f, 0.f};
        for (int st = 0; st < 34; ++st) { const int c = dir == 0 ? st : (st < 2 ? 1 - st : 35 - st);
            f32x2* p = base + (size_t)c * 2048; const f32x2 d = *p; *p = s; s = s * cd + d; }
    }
}
__device__ __forceinline__ void phase_R3(Frame& F, int l) {
    LAS float* qf = (LAS float*)F.lds; LAS float* kf = qf + 128 * 65; LAS float* vf = kf + 128 * 65; LAS float* sc = vf + 128 * 64;
    const float* RS = (const float*)(F.ws + WS_RS); const bf16* PA = (const bf16*)(F.ws + WS_PA); bf16* MIX = (bf16*)(F.ws + WS_HM);
    const int c_lo = (l == 1) ? 2 : 0;
    const int nch = 34 - c_lo;
    for (int u = F.bid; u < 32 * nch; u += F.G) {
        const int bh = u / nch, c = c_lo + u % nch, b = bh >> 2, h = bh & 3;
        const float lf = ret_lg(F, l, 0, h), lb = ret_lg(F, l, 1, h);
        ret_load(F, qf, 65, b, c, 0 + h * 64, true, 1.f);
        ret_load(F, kf, 65, b, c, 256 + h * 64, true, 0.125f);
        ret_load(F, vf, 64, b, c, 512 + h * 64, false, 1.f);
        __syncthreads();
        const float* Sf = RS + (((size_t)bh * 2 + 0) * 34 + c) * 4096; const float* Sb = RS + (((size_t)bh * 2 + 1) * 34 + c) * 4096;
        const int hr = F.tid >> 3, s8 = F.tid & 7;
#pragma unroll 1
        for (int half = 0; half < 2; ++half) {
            const int n = half * 64 + hr;
#pragma unroll 1
            for (int mm = 0; mm < 16; ++mm) { const int m = s8 + 8 * mm; float s = 0.f;
                for (int d = 0; d < 64; ++d) s += qf[n * 65 + d] * kf[m * 65 + d];
                const int df = n - m; float D = 0.f; if (df >= 0) D += __expf(lf * (float)df); if (df <= 0) D += __expf(lb * (float)(-df));
                sc[hr * 128 + m] = s * D; }
            __syncthreads();
            float o[8];
#pragma unroll
            for (int e = 0; e < 8; ++e) o[e] = 0.f;
            for (int m = 0; m < 128; ++m) { const float p = sc[hr * 128 + m];
#pragma unroll
                for (int e = 0; e < 8; ++e) o[e] += p * vf[m * 64 + s8 * 8 + e]; }
            const float qdf = __expf(lf * (float)(n + 1)), qdb = __expf(lb * (float)(128 - n));
            for (int dk = 0; dk < 64; ++dk) { const float q = qf[n * 65 + dk];
                const f32x4 a0 = *(const f32x4*)(Sf + dk * 64 + s8 * 8), a1 = *(const f32x4*)(Sf + dk * 64 + s8 * 8 + 4);
                const f32x4 b0 = *(const f32x4*)(Sb + dk * 64 + s8 * 8), b1 = *(const f32x4*)(Sb + dk * 64 + s8 * 8 + 4);
                const float qa = q * qdf, qb = q * qdb;
                o[0] += qa * a0.x + qb * b0.x; o[1] += qa * a0.y + qb * b0.y; o[2] += qa * a0.z + qb * b0.z; o[3] += qa * a0.w + qb * b0.w;
                o[4] += qa * a1.x + qb * b1.x; o[5] += qa * a1.y + qb * b1.y; o[6] += qa * a1.z + qb * b1.z; o[7] += qa * a1.w + qb * b1.w; }
            float ss = 0.f;
#pragma unroll
            for (int e = 0; e < 8; ++e) ss += o[e] * o[e];
            ss += __shfl_xor(ss, 1); ss += __shfl_xor(ss, 2); ss += __shfl_xor(ss, 4);
            const float rr = 1.0f / sqrtf(ss * (1.f / 64.f) + EPSF);
            const int row = ret_row(b, c, n);
            float gt[8]; load8bf(PA + (size_t)row * 2048 + 768 + h * 64 + s8 * 8, gt);
#pragma unroll
            for (int e = 0; e < 8; ++e) o[e] = o[e] * rr * silu_f(gt[e]);
            store8bf(MIX + (size_t)row * DM + h * 64 + s8 * 8, o);
            __syncthreads();
        }
    }
}

__device__ __forceinline__ void phase_NA(Frame& F, int l) {
    LAS float* sc = (LAS float*)F.lds;
    LAS float* qs = sc + 64 * 388;
    LAS float* rp = qs + 64 * 65;
    const bf16* PB = (const bf16*)(F.ws + WS_PB); bf16* MIX = (bf16*)(F.ws + WS_HM);
    const int n_lat = NB * 8 * 64, n_ctx = (l == 0) ? NB * 8 * 4 : 0;
    for (int u = F.bid; u < n_lat + n_ctx; u += F.G) {
        const bool isl = u < n_lat;
        int b, h, r, qrow0, nkeys;
        if (isl) { b = u >> 9; h = (u >> 6) & 7; r = u & 63; qrow0 = b * SEQ + r * 64; nkeys = 384; }
        else { const int v = u - n_lat; b = v >> 5; h = (v >> 2) & 7; r = v & 3; qrow0 = NLAT + b * CTXL + r * 64; nkeys = 256; }
        const int r0 = min(max(r - 4, 0), 56);
        for (int i = F.tid; i < 64 * 64; i += NTHR) { const int q = i >> 6, d = i & 63; qs[q * 65 + d] = bf2f(PB[(size_t)(qrow0 + q) * 1536 + h * 64 + d]); }
        for (int i = F.tid; i < 465; i += NTHR) rp[i] = F.in[IN_RPB][(size_t)(l * 8 + h) * 465 + i];
        __syncthreads();
        const int qc = F.tid >> 3, s8 = F.tid & 7;
        const int ws = min(max(qc - 8, 0), 48);
        const int ctx0 = NLAT + b * CTXL;
        float mx = -3.0e38f;
        const int nper = nkeys >> 3;
#pragma unroll 1
        for (int ee = 0; ee < nper; ++ee) { const int e = s8 + 8 * ee;
            int krow; float bias = 0.f;
            if (isl && e < 128) { const int i = e >> 4, kcol = ws + (e & 15); krow = b * SEQ + (r0 + i) * 64 + kcol; bias = rp[(r0 + i - r + 7) * 31 + (kcol - qc + 15)]; }
            else krow = ctx0 + (isl ? e - 128 : e);
            const bf16* kp = PB + (size_t)krow * 1536 + 512 + h * 64; float s = 0.f;
#pragma unroll
            for (int d8 = 0; d8 < 8; ++d8) { float kv[8]; load8bf(kp + d8 * 8, kv);
#pragma unroll
                for (int j = 0; j < 8; ++j) s += kv[j] * qs[qc * 65 + d8 * 8 + j]; }
            s = s * 0.125f + bias; sc[qc * 388 + e] = s; mx = fmaxf(mx, s); }
        mx = fmaxf(mx, __shfl_xor(mx, 1)); mx = fmaxf(mx, __shfl_xor(mx, 2)); mx = fmaxf(mx, __shfl_xor(mx, 4));
        float sum = 0.f;
#pragma unroll 1
        for (int ee = 0; ee < nper; ++ee) { const int e = s8 + 8 * ee; const float p = __expf(sc[qc * 388 + e] - mx); sc[qc * 388 + e] = p; sum += p; }
        sum += __shfl_xor(sum, 1); sum += __shfl_xor(sum, 2); sum += __shfl_xor(sum, 4);
        __syncthreads();
        float o[8];
#pragma unroll
        for (int j = 0; j < 8; ++j) o[j] = 0.f;
#pragma unroll 1
        for (int e = 0; e < nkeys; ++e) {
            int krow;
            if (isl && e < 128) { const int i = e >> 4, kcol = ws + (e & 15); krow = b * SEQ + (r0 + i) * 64 + kcol; }
            else krow = ctx0 + (isl ? e - 128 : e);
            float vv[8]; load8bf(PB + (size_t)krow * 1536 + 1024 + h * 64 + s8 * 8, vv);
            const float p = sc[qc * 388 + e];
#pragma unroll
            for (int j = 0; j < 8; ++j) o[j] += p * vv[j]; }
        const float inv = 1.f / sum;
#pragma unroll
        for (int j = 0; j < 8; ++j) o[j] *= inv;
        store8bf(MIX + (size_t)(qrow0 + qc) * DM + 512 + h * 64 + s8 * 8, o);
        __syncthreads();
    }
}

__device__ __forceinline__ void gdn_conv(const Frame& F, int l, LAS float* dst, int pitch, int b, int h, int c, int which) {
    const bf16* PA = (const bf16*)(F.ws + WS_PA);
    const int d = F.tid & 63, t0 = (F.tid >> 6) * 8;
    const int col = 1024 + which * 256 + h * 64 + d;
    float w[5];
#pragma unroll
    for (int j = 0; j < 5; ++j) w[j] = F.in[IN_CONVW][(size_t)(l * 5 + j) * 768 + which * 256 + h * 64 + d];
    const bool isc = c < 4; const int len = isc ? CTXL : SEQ; const int tb = isc ? c * 64 : (c - 4) * 64; const int rowb = isc ? NLAT + b * CTXL : b * SEQ;
    float x[12];
#pragma unroll
    for (int j = 0; j < 12; ++j) { const int t = tb + t0 + j - 2; x[j] = (t >= 0 && t < len) ? bf2f(PA[(size_t)(rowb + t) * 2048 + col]) : 0.f; }
#pragma unroll
    for (int j = 0; j < 8; ++j) { float y = 0.f;
#pragma unroll
        for (int k = 0; k < 5; ++k) y += x[j + k] * w[k];
        dst[(t0 + j) * pitch + d] = silu_f(y); }
}
__device__ __forceinline__ void l2norm_rows(const Frame& F, LAS float* x, int pitch, float scl) {
    const int r = F.tid >> 3, s8 = F.tid & 7; float s = 0.f;
#pragma unroll
    for (int j = 0; j < 8; ++j) { const float v = x[r * pitch + s8 + 8 * j]; s += v * v; }
    s += __shfl_xor(s, 1); s += __shfl_xor(s, 2); s += __shfl_xor(s, 4);
    const float f = scl / sqrtf(s + EPSF);
#pragma unroll
    for (int j = 0; j < 8; ++j) x[r * pitch + s8 + 8 * j] *= f;
}
__device__ __forceinline__ void phase_G1(Frame& F, int l) {
    LAS float* kf = (LAS float*)F.lds; LAS float* vf = kf + 64 * 65; LAS float* Am = vf + 64 * 65;
    LAS float* sol = Am + 2 * 64 * 65;
    LAS float* gcl = sol + 2 * 64 * 128;
    LAS float* btl = gcl + 128;
    const bf16* PC = (const bf16*)(F.ws + WS_PC);
    bf16* GW = (bf16*)(F.ws + WS_GW); bf16* GU = (bf16*)(F.ws + WS_GU); bf16* GK = (bf16*)(F.ws + WS_GK);
    float* GC = (float*)(F.ws + WS_GC); float* GD = (float*)(F.ws + WS_GD);
    for (int u = F.bid; u < 32 * 68; u += F.G) {
        const int bh = u / 68, c = u % 68, b = bh >> 2, h = bh & 3;
        gdn_conv(F, l, kf, 65, b, h, c, 1);
        gdn_conv(F, l, vf, 65, b, h, c, 2);
        if (F.tid < 128) { const int dir = F.tid >> 6, pos = F.tid & 63; const int row = gdn_row(b, c, pos);
            const float a = bf2f(PC[(size_t)row * 256 + dir * 4 + h]), bb = bf2f(PC[(size_t)row * 256 + 8 + dir * 4 + h]);
            const float z = a + F.in[IN_DTB][(l * 2 + dir) * 4 + h];
            const float sp = z > 20.f ? z : log1pf(__expf(z));
            gcl[F.tid] = -__expf(F.in[IN_ALOG][(l * 2 + dir) * 4 + h]) * sp;
            btl[F.tid] = 1.f / (1.f + __expf(-bb)); }
        __syncthreads();
        l2norm_rows(F, kf, 65, 1.f);
        if (F.tid < 2) { const int dir = F.tid; float s = 0.f;
            if (dir == 0) { for (int p = 0; p < 64; ++p) { s += gcl[p]; gcl[p] = s; } }
            else { for (int p = 63; p >= 0; --p) { s += gcl[64 + p]; gcl[64 + p] = s; } } }
        __syncthreads();
#pragma unroll 1
        for (int r = 0; r < 8; ++r) { const int o = F.tid + NTHR * r, i = o >> 6, j = o & 63; float s = 0.f;
            for (int d = 0; d < 64; ++d) s += kf[i * 65 + d] * kf[j * 65 + d];
            Am[i * 65 + j] = (i > j) ? btl[i] * s * __expf(gcl[i] - gcl[j]) : 0.f;
            Am[64 * 65 + i * 65 + j] = (i < j) ? btl[64 + i] * s * __expf(gcl[64 + i] - gcl[64 + j]) : 0.f; }
        __syncthreads();
        if (F.tid < 256) {
            const int dir = F.tid >> 7, col = F.tid & 127; LAS float* so = sol + dir * 64 * 128; const LAS float* A = Am + dir * 64 * 65;
#pragma unroll 1
            for (int st = 0; st < 64; ++st) { const int i = dir ? 63 - st : st;
                float v = (col < 64) ? vf[i * 65 + col] * btl[dir * 64 + i] : kf[i * 65 + col - 64] * btl[dir * 64 + i] * __expf(gcl[dir * 64 + i]);
                for (int s2 = 0; s2 < st; ++s2) { const int j = dir ? 63 - s2 : s2; v -= A[i * 65 + j] * so[j * 128 + col]; }
                so[i * 128 + col] = v; }
            const int seq = bh * 2 + dir; const size_t cb = ((size_t)seq * 68 + c) * 4096;
            if (col < 64) { for (int p = 0; p < 64; ++p) GU[cb + p * 64 + col] = (bf16)f2bf(so[p * 128 + col]); }
            else { for (int p = 0; p < 64; ++p) GW[cb + p * 64 + col - 64] = (bf16)f2bf(so[p * 128 + col]); }
        }
        for (int i = F.tid; i < 2 * 4096; i += NTHR) { const int dir = i >> 12, dk = (i >> 6) & 63, pos = i & 63;
            const float gl = dir ? gcl[64] : gcl[63];
            GK[((size_t)(bh * 2 + dir) * 68 + c) * 4096 + dk * 64 + pos] = (bf16)f2bf(kf[pos * 65 + dk] * __expf(gl - gcl[dir * 64 + pos])); }
        if (F.tid < 128) { const int dir = F.tid >> 6, pos = F.tid & 63; GC[((size_t)(bh * 2 + dir) * 68 + c) * 64 + pos] = gcl[F.tid];
            if (pos == 0) GD[(bh * 2 + dir) * 68 + c] = __expf(dir ? gcl[64] : gcl[63]); }
        __syncthreads();
    }
}
__device__ __forceinline__ void phase_G2(Frame& F, int l) {
    LAS float* ST = (LAS float*)F.lds; LAS float* VN = ST + 16 * 65;
    const bf16* GW = (const bf16*)(F.ws + WS_GW); const bf16* GU = (const bf16*)(F.ws + WS_GU); const bf16* GK = (const bf16*)(F.ws + WS_GK);
    const float* GD = (const float*)(F.ws + WS_GD);
    bf16* GS = (bf16*)(F.ws + WS_GS); bf16* GV = (bf16*)(F.ws + WS_GV);
    for (int u = F.bid; u < 256; u += F.G) {
        const int seq = u >> 2, vs = u & 3, dir = seq & 1;
        for (int i = F.tid; i < 16 * 65; i += NTHR) ST[i] = 0.f;
        __syncthreads();
#pragma unroll 1
        for (int st = 0; st < 68; ++st) {
            const int c = dir == 0 ? st : (st < 4 ? 3 - st : 71 - st);
            const size_t cb = ((size_t)seq * 68 + c) * 4096;
            const float dec = GD[seq * 68 + c];
            { const int pos = F.tid & 63, dvp = F.tid >> 6;
              float a0 = bf2f(GU[cb + pos * 64 + 16 * vs + 2 * dvp]), a1 = bf2f(GU[cb + pos * 64 + 16 * vs + 2 * dvp + 1]);
#pragma unroll
              for (int d8 = 0; d8 < 8; ++d8) { float w[8]; load8bf(GW + cb + pos * 64 + d8 * 8, w);
#pragma unroll
                  for (int j = 0; j < 8; ++j) { a0 -= w[j] * ST[(2 * dvp) * 65 + d8 * 8 + j]; a1 -= w[j] * ST[(2 * dvp + 1) * 65 + d8 * 8 + j]; } }
              VN[(2 * dvp) * 65 + pos] = a0; VN[(2 * dvp + 1) * 65 + pos] = a1;
              GV[cb + (size_t)(16 * vs + 2 * dvp) * 64 + pos] = (bf16)f2bf(a0); GV[cb + (size_t)(16 * vs + 2 * dvp + 1) * 64 + pos] = (bf16)f2bf(a1);
              GS[cb + (size_t)(16 * vs + 2 * dvp) * 64 + pos] = (bf16)f2bf(ST[(2 * dvp) * 65 + pos]); GS[cb + (size_t)(16 * vs + 2 * dvp + 1) * 64 + pos] = (bf16)f2bf(ST[(2 * dvp + 1) * 65 + pos]); }
            __syncthreads();
            { const int dk = F.tid & 63, dvp = F.tid >> 6;
              float s0 = ST[(2 * dvp) * 65 + dk] * dec, s1 = ST[(2 * dvp + 1) * 65 + dk] * dec;
#pragma unroll
              for (int p8 = 0; p8 < 8; ++p8) { float kk[8]; load8bf(GK + cb + dk * 64 + p8 * 8, kk);
#pragma unroll
                  for (int j = 0; j < 8; ++j) { s0 += kk[j] * VN[(2 * dvp) * 65 + p8 * 8 + j]; s1 += kk[j] * VN[(2 * dvp + 1) * 65 + p8 * 8 + j]; } }
              ST[(2 * dvp) * 65 + dk] = s0; ST[(2 * dvp + 1) * 65 + dk] = s1; }
            __syncthreads();
        }
    }
}
__device__ __forceinline__ void phase_G3(Frame& F, int l) {
    LAS float* qf = (LAS float*)F.lds; LAS float* kf = qf + 64 * 65; LAS float* at = kf + 64 * 65; LAS float* STl = at + 64 * 65; LAS float* VTl = STl + 64 * 65; LAS float* gcl = VTl + 64 * 65;
    const bf16* PA = (const bf16*)(F.ws + WS_PA); bf16* MIX = (bf16*)(F.ws + WS_HM);
    const bf16* GS = (const bf16*)(F.ws + WS_GS); const bf16* GV = (const bf16*)(F.ws + WS_GV); const float* GC = (const float*)(F.ws + WS_GC);
    const int c_lo = (l == 1) ? 4 : 0, nch = 68 - c_lo;
    for (int u = F.bid; u < 32 * nch; u += F.G) {
        const int bh = u / nch, c = c_lo + u % nch, b = bh >> 2, h = bh & 3;
        gdn_conv(F, l, qf, 65, b, h, c, 0);
        gdn_conv(F, l, kf, 65, b, h, c, 1);
        __syncthreads();
        l2norm_rows(F, qf, 65, 0.125f);
        l2norm_rows(F, kf, 65, 1.f);
        const int pos = F.tid >> 3, s8 = F.tid & 7;
        float o[8];
#pragma unroll
        for (int e = 0; e < 8; ++e) o[e] = 0.f;
#pragma unroll 1
        for (int dir = 0; dir < 2; ++dir) {
            const size_t cb = ((size_t)(bh * 2 + dir) * 68 + c) * 4096;
            __syncthreads();
            for (int i = F.tid; i < 4096; i += NTHR) { const int a = i >> 6, bq = i & 63; STl[a * 65 + bq] = bf2f(GS[cb + i]); VTl[a * 65 + bq] = bf2f(GV[cb + i]); }
            if (F.tid < 64) gcl[F.tid] = GC[((size_t)(bh * 2 + dir) * 68 + c) * 64 + F.tid];
            __syncthreads();
#pragma unroll 1
            for (int jj = 0; jj < 8; ++jj) { const int j = s8 + 8 * jj; float s = 0.f;
                for (int d = 0; d < 64; ++d) s += qf[pos * 65 + d] * kf[j * 65 + d];
                const bool ok = dir ? (j >= pos) : (j <= pos);
                at[pos * 65 + j] = ok ? s * __expf(gcl[pos] - gcl[j]) : 0.f; }
            __syncthreads();
            const float eg = __expf(gcl[pos]);
#pragma unroll
            for (int e = 0; e < 8; ++e) { const int dv = s8 * 8 + e; float s = 0.f;
                for (int d = 0; d < 64; ++d) s += qf[pos * 65 + d] * STl[dv * 65 + d];
                float s2 = 0.f;
                for (int j = 0; j < 64; ++j) s2 += at[pos * 65 + j] * VTl[dv * 65 + j];
                o[e] += s * eg + s2; }
        }
        float ss = 0.f;
#pragma unroll
        for (int e = 0; e < 8; ++e) ss += o[e] * o[e];
        ss += __shfl_xor(ss, 1); ss += __shfl_xor(ss, 2); ss += __shfl_xor(ss, 4);
        const float rr = 1.0f / sqrtf(ss * (1.f / 64.f) + EPSF);
        const int row = gdn_row(b, c, pos);
        float gt[8]; load8bf(PA + (size_t)row * 2048 + 1792 + h * 64 + s8 * 8, gt);
#pragma unroll
        for (int e = 0; e < 8; ++e) o[e] = o[e] * rr * F.in[IN_GNG][l * 64 + s8 * 8 + e] * silu_f(gt[e]);
        store8bf(MIX + (size_t)row * DM + 256 + h * 64 + s8 * 8, o);
        __syncthreads();
    }
}

constexpr int NPL = 12, PH_FINAL = 1 + 2 * NPL, NPHASES = PH_FINAL + 1;
struct Args { const float* in[24]; float* out; unsigned char* ws; int ph_lo, ph_hi; };

__global__ void __launch_bounds__(NTHR, 2) fwd(Args args) {
    extern __shared__ __attribute__((aligned(16))) unsigned char lds_raw[];
    Frame F;
    F.lds = (LAS unsigned char*)lds_raw;
    F.tid = threadIdx.x; F.lane = F.tid & 63; F.wave = __builtin_amdgcn_readfirstlane(F.tid >> 6); F.G = gridDim.x; F.bid = blockIdx.x;
    F.in = (const float* const __attribute__((address_space(4)))*)__builtin_amdgcn_kernarg_segment_ptr();
    F.out = args.out; F.ws = args.ws;
    volatile LAS unsigned* MISC = (volatile LAS unsigned*)(F.lds + MISC_OFF);
    if (F.tid < 16) MISC[F.tid] = 0u;
    __syncthreads();
    unsigned* ctl = (unsigned*)(F.ws + WS_CTL);
    const int lo = args.ph_lo, hi = args.ph_hi;
    XcdBarrier bar; bar.bar = ctl + CW_BAR; bar.x = 0; bar.st = nullptr;
    if (hi - lo > 1) bar = xcd_barrier_post(ctl + CW_BAR, MISC + 8);
#ifndef SITE_MASK
#define SITE_MASK 0xFFFFu
#endif
#define SITE(i) (((SITE_MASK) >> (i)) & 1u)
#define IN(k) (lo <= (k) && (k) < hi)
#define SEAM(k) do { if ((k) + 1 < hi) xcd_barrier(bar); } while (0)

    if (SITE(0) && IN(0)) { phase_prologue(F); SEAM(0); }

#pragma unroll 1
    for (int l = 0; l < 2; ++l) {
        const int pb = 1 + l * NPL;
        asm volatile("" : "+s"(F.bid), "+s"(F.G)); asm volatile("" : "+v"(F.tid));
        F.lane = F.tid & 63; F.wave = __builtin_amdgcn_readfirstlane(F.tid >> 6);
        const float* xl = l == 0 ? F.in[IN_X] : F.out;
        const float* xc = l == 0 ? F.in[IN_CTX] : (const float*)(F.ws + WS_XC);
        if (SITE(1) && IN(pb + 0)) { phase_norm(F, l, 0, xl, xc, MT); SEAM(pb + 0); }
        if (SITE(2) && IN(pb + 1)) {
            pg8::Gemm g{(const bf16*)(F.ws + WS_HM), (const bf16*)(F.ws + WS_WIN) + (size_t)l * NIN * DM, DM};
            pg8::SchedStatic S{MT / 256, NIN / 256, F.G, F.bid};
            pg8::EpiInProj E{(bf16*)(F.ws + WS_PA), (bf16*)(F.ws + WS_PB), (bf16*)(F.ws + WS_PC)};
            pg8::gemm_phase(F.lds, g, S, E, F.tid);
            SEAM(pb + 1);
        }
        if (SITE(3) && IN(pb + 2)) { phase_R1(F, l); phase_NA(F, l); SEAM(pb + 2); }
        if (SITE(4) && IN(pb + 3)) { phase_R2(F, l); phase_G1(F, l); SEAM(pb + 3); }
        if (SITE(5) && IN(pb + 4)) { phase_G2(F, l); SEAM(pb + 4); }
        if (SITE(6) && IN(pb + 5)) { phase_G3(F, l); phase_R3(F, l); SEAM(pb + 5); }
        if (SITE(7) && IN(pb + 6)) {
            pg8::Gemm g{(const bf16*)(F.ws + WS_HM), (const bf16*)(F.ws + WS_WOUT) + (size_t)l * DM * DM, DM};
            pg8::SchedStatic S{(l == 0 ? MT : NLAT) / 256, DM / 256, F.G, F.bid};
            pg8::EpiResGate E{xl, xc, F.out, (float*)(F.ws + WS_XC), (const float*)(F.ws + WS_MOD) + (size_t)(l * 9) * 6144 + 2 * 1024};
            pg8::gemm_phase(F.lds, g, S, E, F.tid);
            SEAM(pb + 6);
        }
        if (SITE(8) && IN(pb + 7)) {
            if (l == 0) phase_norm(F, l, 1, F.out, (const float*)(F.ws + WS_XC), MT);
            else { phase_norm_route(F, l, F.out); __syncthreads(); moe_weight_copy(F); }
            SEAM(pb + 7);
        }
        if (l == 0) {
            if (SITE(9) && IN(pb + 8)) {
                pg8::Gemm g{(const bf16*)(F.ws + WS_HM), (const bf16*)(F.ws + WS_W13D), DM};
                pg8::SchedStatic S{MT / 256, 2 * DFF / 256, F.G, F.bid};
                pg8::EpiSwiglu E{(bf16*)(F.ws + WS_ACTD)};
                pg8::gemm_phase(F.lds, g, S, E, F.tid);
                SEAM(pb + 8);
            }
            if (SITE(10) && IN(pb + 9)) {
                pg8::Gemm g{(const bf16*)(F.ws + WS_ACTD), (const bf16*)(F.ws + WS_W2D), DFF};
                pg8::SchedStatic S{MT / 256, DM / 256, F.G, F.bid};
                pg8::EpiResGate E{F.out, (const float*)(F.ws + WS_XC), F.out, (float*)(F.ws + WS_XC), (const float*)(F.ws + WS_MOD) + (size_t)(l * 9) * 6144 + 5 * 1024};
                pg8::gemm_phase(F.lds, g, S, E, F.tid);
                SEAM(pb + 9);
            }
        } else {
#pragma unroll 1
            for (int pass = 0; pass < 2; ++pass) {
                asm volatile("" : "+s"(F.bid), "+s"(F.G)); asm volatile("" : "+v"(F.tid));
                F.lane = F.tid & 63; F.wave = __builtin_amdgcn_readfirstlane(F.tid >> 6);
                const bool do_up = SITE(11) && IN(pb + 8 + 2 * pass), do_dn = SITE(12) && IN(pb + 9 + 2 * pass);
                if (do_up || do_dn) {
#define MOE_SCHED_INIT(S) do { const unsigned* gcnt = (const unsigned*)(F.ws + WS_CTL) + CW_CNT; int accT = 0; \
                        _Pragma("unroll") for (int e = 0; e < 8; ++e) { const int cn = (int)gcnt[e]; S.cn[e] = cn; S.ts[e] = accT; accT += (cn + 255) >> 8; } \
                        S.ts[8] = accT; S.t0 = pass * MOE_CAP_TILES; { int n = accT - S.t0; n = n < 0 ? 0 : n; S.nM = n > MOE_CAP_TILES ? MOE_CAP_TILES : n; } \
                        S.G = F.G; S.c = F.bid; S.tokslot = (const int*)(F.ws + WS_TOKSLOT); } while (0)
                    if (do_up) {
                        pg8::SchedMoe<true> S; MOE_SCHED_INIT(S);
                        S.nN = 2 * DFF / 256;
                        pg8::Gemm g{(const bf16*)(F.ws + WS_HM), (const bf16*)(F.ws + WS_MW13), DM};
                        pg8::EpiSwiglu E{(bf16*)(F.ws + WS_ACTM)};
                        pg8::gemm_phase(F.lds, g, S, E, F.tid);
                        SEAM(pb + 8 + 2 * pass);
                    }
                    if (do_dn) {
                        pg8::SchedMoe<false> S; MOE_SCHED_INIT(S);
                        S.nN = DM / 256;
                        pg8::Gemm g{(const bf16*)(F.ws + WS_ACTM), (const bf16*)(F.ws + WS_MW2), DFF};
                        pg8::EpiPlain E{(bf16*)(F.ws + WS_Y), DM};
                        pg8::gemm_phase(F.lds, g, S, E, F.tid);
                        SEAM(pb + 9 + 2 * pass);
                    }
                }
            }
        }
    }
    if (SITE(13) && IN(PH_FINAL)) phase_final(F);
#undef IN
#undef SEAM
}

extern "C" void kernel_launch(void* const* d_in, const int* in_sizes, int n_in, void* d_out, int out_size, void* d_ws, size_t ws_size, hipStream_t stream) {
    static int grid = 0;
    if (grid == 0) {
        if (n_in != 24 || out_size != NLAT * DM || ws_size < WS_NEED) { fprintf(stderr, "kernel_launch: unexpected problem: n_in %d out %d ws %zu (need %zu)\n", n_in, out_size, ws_size, (size_t)WS_NEED); grid = -1; return; }
        int dev = 0, cus = 0, per_cu = 0;
        if (hipGetDevice(&dev) != hipSuccess || hipDeviceGetAttribute(&cus, hipDeviceAttributeMultiprocessorCount, dev) != hipSuccess) { grid = -1; return; }
        if (hipFuncSetAttribute((const void*)fwd, hipFuncAttributeMaxDynamicSharedMemorySize, LDS_BYTES) != hipSuccess) { fprintf(stderr, "kernel_launch: hipFuncSetAttribute failed\n"); grid = -1; return; }
        if (hipOccupancyMaxActiveBlocksPerMultiprocessor(&per_cu, (const void*)fwd, NTHR, LDS_BYTES) != hipSuccess || per_cu < 1) { fprintf(stderr, "kernel_launch: occupancy query says %d\n", per_cu); }
        (void)hipGetLastError();
        grid = cus;
    }
    if (grid < 0) return;
    (void)hipMemsetAsync((char*)d_ws + WS_CTL, 0, CTL_ZERO_BYTES, stream);
    Args a{};
    for (int i = 0; i < 24; ++i) a.in[i] = (const float*)d_in[i];
    a.out = (float*)d_out; a.ws = (unsigned char*)d_ws;
#if MK_ONE_LAUNCH
    a.ph_lo = 0; a.ph_hi = NPHASES;
    hipLaunchKernelGGL(fwd, dim3(grid), dim3(NTHR), LDS_BYTES, stream, a);
#else
    for (int p = 0; p < NPHASES; ++p) {
        if (p >= 1 + 10 && p < 1 + NPL) continue;
        a.ph_lo = p; a.ph_hi = p + 1;
        hipLaunchKernelGGL(fwd, dim3(grid), dim3(NTHR), LDS_BYTES, stream, a);
    }
#endif
}
```

```cpp
#include <hip/hip_runtime.h>
#include <cstdio>
#include <cstdint>

#ifndef MK_ONE_LAUNCH
#define MK_ONE_LAUNCH 1
#endif

#define GAS __attribute__((address_space(1)))
#define LAS __attribute__((address_space(3)))
typedef unsigned short bf16;
typedef short bf16x8 __attribute__((ext_vector_type(8)));
typedef float f32x4 __attribute__((ext_vector_type(4)));
typedef float f32x2 __attribute__((ext_vector_type(2)));
typedef unsigned u32x4 __attribute__((ext_vector_type(4)));
typedef unsigned u32x2 __attribute__((ext_vector_type(2)));

constexpr int NB = 8, SEQ = 4096, CTXL = 256, DM = 1024, NLAT = NB * SEQ, NCTX = NB * CTXL, MT = NLAT + NCTX;
constexpr int DFF = 2816, NEXP = 8, NIN = 3840, NINSRC = 3600;
constexpr int NWAVES = 8, NTHR = 512;
constexpr float EPSF = 1e-6f;
constexpr int MOE_CAP_TILES = 132;
constexpr int YROWS = 67584;

constexpr size_t MiB = 1u << 20;
constexpr size_t WS_CTL = 0, CTL_ZERO_BYTES = 1 * MiB;
constexpr size_t WS_MOD = 1 * MiB;
constexpr size_t WS_ROPE = WS_MOD + 2 * 9 * 6144 * 4;
constexpr size_t WS_TOKSLOT = 2 * MiB;
constexpr size_t WS_RINFO = 3 * MiB;
constexpr size_t WS_HM = 4 * MiB;
constexpr size_t SZ_HM = (size_t)MT * DM * 2;
constexpr size_t WS_R = WS_HM + SZ_HM;
constexpr size_t WS_WIN = WS_R;
constexpr size_t WS_WOUT = WS_WIN + (size_t)2 * NIN * DM * 2;
constexpr size_t WS_W13D = WS_WOUT + (size_t)2 * DM * DM * 2;
constexpr size_t WS_W2D = WS_W13D + (size_t)2 * DFF * DM * 2;
constexpr size_t WS_XC = WS_W2D + (size_t)DM * DFF * 2;
constexpr size_t WS_GC = WS_XC + (size_t)NCTX * DM * 4;
constexpr size_t WS_GD = WS_GC + (size_t)64 * 68 * 64 * 4;
constexpr size_t WS_RS = WS_GD + 32768;
constexpr size_t WS_GS = WS_RS + (size_t)32 * 2 * 34 * 4096 * 4;
constexpr size_t WS_GV = WS_GS + (size_t)64 * 68 * 4096 * 2;
constexpr size_t WS_PA = WS_GV + (size_t)64 * 68 * 4096 * 2;
constexpr size_t WS_PB = WS_PA + (size_t)MT * 2048 * 2;
constexpr size_t WS_PC = WS_PB + (size_t)MT * 1536 * 2;
constexpr size_t WS_LAYER_END = WS_PC + (size_t)MT * 256 * 2;
constexpr size_t WS_GW = WS_PB;
constexpr size_t WS_GU = WS_GW + (size_t)64 * 68 * 4096 * 2;
constexpr size_t WS_GK = WS_GU + (size_t)64 * 68 * 4096 * 2;
constexpr size_t WS_ACTD = WS_PA;
constexpr size_t WS_MW13 = WS_HM + (size_t)NLAT * DM * 2;
constexpr size_t WS_MW2 = WS_MW13 + (size_t)NEXP * 2 * DFF * DM * 2;
constexpr size_t WS_ACTM = WS_MW2 + (size_t)NEXP * DM * DFF * 2;
constexpr size_t WS_Y = WS_ACTM + (size_t)MOE_CAP_TILES * 256 * DFF * 2;
constexpr size_t WS_MOE_END = WS_Y + (size_t)YROWS * DM * 2;
constexpr size_t WS_NEED = WS_LAYER_END > WS_MOE_END ? WS_LAYER_END : WS_MOE_END;
static_assert(WS_ACTD + (size_t)MT * DFF * 2 <= WS_PC, "dense ACT overlay");
static_assert(WS_GK + (size_t)64 * 68 * 4096 * 2 <= WS_PC, "GDN W/U/K overlay");
static_assert(WS_NEED <= 542445312ull, "workspace budget");

constexpr int CW_TMO = 0, CW_CNT = 64, CW_BAR = 4096;

constexpr int LDS_BYTES = 147456, MISC_OFF = 147200;

__device__ __forceinline__ float bf2f(bf16 v) { return __uint_as_float((unsigned)v << 16); }
__device__ __forceinline__ unsigned f2bf(float f) { unsigned u = __float_as_uint(f); return (u + 0x7fffu + ((u >> 16) & 1u)) >> 16; }
__device__ __forceinline__ unsigned pk2(float lo, float hi) { return f2bf(lo) | (f2bf(hi) << 16); }
__device__ __forceinline__ float silu_f(float x) { return x / (1.f + __expf(-x)); }
__device__ __forceinline__ float wave_sum(float v) {
#pragma unroll
    for (int o = 1; o < 64; o <<= 1) v += __shfl_xor(v, o);
    return v;
}
__device__ __forceinline__ void load8bf(const bf16* p, float (&o)[8]) {
    const u32x4 w = *(const u32x4*)p;
    o[0] = __uint_as_float(w.x << 16); o[1] = __uint_as_float(w.x & 0xffff0000u);
    o[2] = __uint_as_float(w.y << 16); o[3] = __uint_as_float(w.y & 0xffff0000u);
    o[4] = __uint_as_float(w.z << 16); o[5] = __uint_as_float(w.z & 0xffff0000u);
    o[6] = __uint_as_float(w.w << 16); o[7] = __uint_as_float(w.w & 0xffff0000u);
}
__device__ __forceinline__ void store8bf(bf16* p, const float (&v)[8]) {
    u32x4 w; w.x = pk2(v[0], v[1]); w.y = pk2(v[2], v[3]); w.z = pk2(v[4], v[5]); w.w = pk2(v[6], v[7]);
    *(u32x4*)p = w;
}

#define XB_TMO      128
#define XB_XCNT(j)  (256  + 64 * (j))
#define XB_XSUB(j)  (1280 + 64 * (j))
#define XB_XGEN(j)  (2304 + 64 * (j))
#define XB_TOP      3328
#define XB_TOPGEN   3392
#define XCD_BAR_WORDS 3456
#define XB_SPIN_CAP (1u << 22)
__device__ __forceinline__ unsigned xb_ld(unsigned* p)              { return __hip_atomic_load(p, __ATOMIC_RELAXED, __HIP_MEMORY_SCOPE_AGENT); }
__device__ __forceinline__ unsigned xb_add(unsigned* p, unsigned v) { return __hip_atomic_fetch_add(p, v, __ATOMIC_RELAXED, __HIP_MEMORY_SCOPE_AGENT); }
__device__ __forceinline__ unsigned xb_xcc_id() { return (unsigned)__builtin_amdgcn_s_getreg((3 << 11) | 20) & 0xFu; }
#define XB_SPIN(cond, bar) do { unsigned _sp = 0; while (cond) { __builtin_amdgcn_s_sleep(1); \
    if ((++_sp & 255u) == 0u) { if (xb_ld(&(bar)[XB_TMO])) break; if (_sp > XB_SPIN_CAP) { atomicAdd(&(bar)[XB_TMO], 1u); break; } } } } while (0)
struct XcdBarrier { unsigned* bar; unsigned x; volatile LAS unsigned* st; };
__device__ __forceinline__ XcdBarrier xcd_barrier_post(unsigned* bar, volatile LAS unsigned* st) {
    XcdBarrier b; b.bar = bar; b.x = xb_xcc_id(); b.st = st;
    if (threadIdx.x == 0) (void)xb_add(&bar[XB_XCNT(b.x)], 1u);
    return b;
}
__device__ __forceinline__ void xcd_barrier_complete(unsigned* bar, unsigned x, unsigned& nloc, unsigned& nx) {
    const unsigned G = gridDim.x * gridDim.y * gridDim.z;
    unsigned sum, cnt, mine, sp = 0u;
    for (;;) {
        sum = 0u; cnt = 0u; mine = 0u;
#pragma unroll
        for (unsigned j = 0; j < 16; ++j) { const unsigned c = xb_ld(&bar[XB_XCNT(j)]); sum += c; cnt += (c > 0u) ? 1u : 0u; mine = (j == x) ? c : mine; }
        if (sum == G) break;
        __builtin_amdgcn_s_sleep(1);
        if ((++sp & 255u) == 0u) { if (xb_ld(&bar[XB_TMO])) break; if (sp > XB_SPIN_CAP) { atomicAdd(&bar[XB_TMO], 1u); break; } }
    }
    nloc = mine > 0u ? mine : 1u; nx = cnt > 0u ? cnt : 1u;
}
__device__ __forceinline__ void xcd_barrier(const XcdBarrier& b) {
    asm volatile("s_waitcnt vmcnt(0)" ::: "memory");
    __syncthreads();
    if (threadIdx.x == 0) {
        unsigned* bar = b.bar;
        __builtin_amdgcn_s_waitcnt(0);
        unsigned nloc = b.st[0], nx = b.st[1];
        if (nloc == 0u) { xcd_barrier_complete(bar, b.x, nloc, nx); b.st[0] = nloc; b.st[1] = nx; }
        const unsigned old = xb_add(&bar[XB_XSUB(b.x)], 1u);
        const unsigned gen = old / nloc;
        if (old + 1u == (gen + 1u) * nloc) {
            __builtin_amdgcn_fence(__ATOMIC_RELEASE, "agent");
            asm volatile("s_waitcnt vmcnt(0)" ::: "memory");
            const unsigned og = xb_add(&bar[XB_TOP], 1u);
            const unsigned tg = og / nx;
            if (og + 1u == (tg + 1u) * nx) xb_add(&bar[XB_TOPGEN], 1u);
            else XB_SPIN(xb_ld(&bar[XB_TOPGEN]) == tg, bar);
            __builtin_amdgcn_fence(__ATOMIC_ACQUIRE, "agent");
            xb_add(&bar[XB_XGEN(b.x)], 1u);
            asm volatile("s_waitcnt vmcnt(0)" ::: "memory");
        } else {
            XB_SPIN(xb_ld(&bar[XB_XGEN(b.x)]) == gen, bar);
            __builtin_amdgcn_fence(__ATOMIC_ACQUIRE, "agent");
            asm volatile("s_waitcnt vmcnt(0)" ::: "memory");
        }
    }
    __syncthreads();
}

namespace pg8 {
constexpr int BM = 256, BK = 64, HALF = 128, HTB = HALF * BK * 2, STAGE_BYTES = 8 * HTB, NXCD = 8, WGM = 8;
__host__ __device__ __forceinline__ int lds_byte(int r, int c) { const int st = (r >> 4) * 2 + (c >> 5), rr = r & 15, cc = c & 31, ob = rr * 64 + cc * 2; return st * 1024 + (ob ^ (((ob >> 9) & 1) << 5)); }
__host__ __device__ __forceinline__ void stage_rc(int b, int& R, int& C) { const int st = b / 1024, sb = b % 1024, swz = sb ^ (((sb >> 9) & 1) << 5); R = (st >> 1) * 16 + swz / 64; C = (st & 1) * 32 + (swz % 64) / 2; }
__host__ __device__ __forceinline__ int perm32(int rho) { const int n = rho >> 4, i = rho & 15; return 8 * (i >> 2) + 4 * n + (i & 3); }

struct Unit { int pm, pn, e, T, cnt, pml; };
struct Gemm { const bf16* A; const bf16* Bt; int K; };

__device__ __forceinline__ bool decode_tile(int i, int G, int c, int nM, int nN, int& pm, int& pn) {
    const int nwg = nM * nN; const long L = (long)i * G + c; if (L >= nwg) return false;
    int wgid = (int)L; { const int q = nwg / NXCD, r = nwg % NXCD, xcd = wgid % NXCD, off = wgid / NXCD; wgid = (xcd < r ? xcd * (q + 1) : r * (q + 1) + (xcd - r) * q) + off; }
    const int nig = WGM * nN, gid = wgid / nig, fm = gid * WGM, gsz = (nM - fm) < WGM ? (nM - fm) : WGM;
    pm = fm + ((wgid % nig) % gsz); pn = (wgid % nig) / gsz; return true;
}
struct SchedStatic {
    static constexpr bool GATHER = false;
    int nM, nN, G, c;
    __device__ __forceinline__ bool next(int i, Unit& u) const { u.e = 0; u.T = 0; u.cnt = 0; u.pml = 0; return decode_tile(i, G, c, nM, nN, u.pm, u.pn); }
    __device__ __forceinline__ int a_row(const Unit& u, int r) const { return u.pm * BM + r; }
    __device__ __forceinline__ int a_row0(const Unit& u) const { return u.pm * BM; }
    __device__ __forceinline__ int b_row0(const Unit& u) const { return u.pn * BM; }
};
template <bool UP> struct SchedMoe {
    static constexpr bool GATHER = UP;
    int nM, nN, G, c, t0;
    int ts[9], cn[8]; const int* tokslot;
    __device__ __forceinline__ bool next(int i, Unit& u) const {
        if (!decode_tile(i, G, c, nM, nN, u.pm, u.pn)) return false;
        const int T = t0 + u.pm; int e = 0;
#pragma unroll
        for (int k = 1; k < 8; ++k) e += (T >= ts[k]) ? 1 : 0;
        int tse = 0, cne = 0;
#pragma unroll
        for (int k = 0; k < 8; ++k) { tse = (k == e) ? ts[k] : tse; cne = (k == e) ? cn[k] : cne; }
        u.e = e; u.T = T; u.pml = T - tse; u.cnt = cne; return true;
    }
    __device__ __forceinline__ int a_row(const Unit& u, int r) const {
        if (UP) { const int slot = u.pml * BM + r; return slot < u.cnt ? tokslot[u.e * 32768 + slot] : 0; }
        return u.pm * BM + r;
    }
    __device__ __forceinline__ int a_row0(const Unit& u) const { return u.pm * BM; }
    __device__ __forceinline__ int b_row0(const Unit& u) const { return u.e * (UP ? 2 * DFF : DM) + u.pn * BM; }
};

__device__ __forceinline__ unsigned cvt_pk_bf16(float lo, float hi) { unsigned r; asm volatile("v_cvt_pk_bf16_f32 %0, %1, %2" : "=v"(r) : "v"(lo), "v"(hi)); return r; }

struct EpiInProj {
    static constexpr bool PERM = true;
    bf16 *PA, *PB, *PC;
    __device__ __forceinline__ void operator()(const f32x4 (&acc)[2][2][4][2], const Unit& u, int wr, int wc, int fr, int fq) const {
        bf16* base; int ldc, colt;
        if (u.pn < 8) { base = PA; ldc = 2048; colt = u.pn * 256; } else if (u.pn < 14) { base = PB; ldc = 1536; colt = (u.pn - 8) * 256; } else { base = PC; ldc = 256; colt = 0; }
        const int row0 = u.pm * BM + wr * 64 + fr, col0 = colt + wc * 32 + 8 * fq;
#pragma unroll
        for (int ai = 0; ai < 2; ++ai)
#pragma unroll
            for (int m = 0; m < 4; ++m) { bf16* rowp = base + (size_t)(row0 + ai * HALF + m * 16) * ldc + col0;
#pragma unroll
                for (int bj = 0; bj < 2; ++bj) { const f32x4 v0 = acc[ai][bj][m][0], v1 = acc[ai][bj][m][1];
                    u32x4 w; w.x = cvt_pk_bf16(v0[0], v0[1]); w.y = cvt_pk_bf16(v0[2], v0[3]); w.z = cvt_pk_bf16(v1[0], v1[1]); w.w = cvt_pk_bf16(v1[2], v1[3]);
                    *(u32x4*)(rowp + bj * HALF) = w; } }
    }
};
struct EpiPlain {
    static constexpr bool PERM = true;
    bf16* O; int ldc;
    __device__ __forceinline__ void operator()(const f32x4 (&acc)[2][2][4][2], const Unit& u, int wr, int wc, int fr, int fq) const {
        const int row0 = u.T * BM + wr * 64 + fr, col0 = u.pn * 256 + wc * 32 + 8 * fq;
#pragma unroll
        for (int ai = 0; ai < 2; ++ai)
#pragma unroll
            for (int m = 0; m < 4; ++m) { bf16* rowp = O + (size_t)(row0 + ai * HALF + m * 16) * ldc + col0;
#pragma unroll
                for (int bj = 0; bj < 2; ++bj) { const f32x4 v0 = acc[ai][bj][m][0], v1 = acc[ai][bj][m][1];
                    u32x4 w; w.x = cvt_pk_bf16(v0[0], v0[1]); w.y = cvt_pk_bf16(v0[2], v0[3]); w.z = cvt_pk_bf16(v1[0], v1[1]); w.w = cvt_pk_bf16(v1[2], v1[3]);
                    *(u32x4*)(rowp + bj * HALF) = w; } }
    }
};
struct EpiSwiglu {
    static constexpr bool PERM = true;
    bf16* O;
    __device__ __forceinline__ void operator()(const f32x4 (&acc)[2][2][4][2], const Unit& u, int wr, int wc, int fr, int fq) const {
        const int row0 = u.pm * BM + wr * 64 + fr, col0 = u.pn * 128 + wc * 32 + 8 * fq;
#pragma unroll
        for (int ai = 0; ai < 2; ++ai)
#pragma unroll
            for (int m = 0; m < 4; ++m) { bf16* rowp = O + (size_t)(row0 + ai * HALF + m * 16) * DFF + col0;
                float r[8];
#pragma unroll
                for (int n = 0; n < 2; ++n)
#pragma unroll
                    for (int j = 0; j < 4; ++j) { const float a = acc[ai][0][m][n][j], b = acc[ai][1][m][n][j]; r[n * 4 + j] = a * b * __builtin_amdgcn_rcpf(1.f + __expf(-a)); }
                u32x4 w; w.x = cvt_pk_bf16(r[0], r[1]); w.y = cvt_pk_bf16(r[2], r[3]); w.z = cvt_pk_bf16(r[4], r[5]); w.w = cvt_pk_bf16(r[6], r[7]);
                *(u32x4*)rowp = w; }
    }
};
struct EpiResGate {
    static constexpr bool PERM = false;
    const float* resL; const float* resC; float* outL; float* outC; const float* gate;
    __device__ __forceinline__ void operator()(const f32x4 (&acc)[2][2][4][2], const Unit& u, int wr, int wc, int fr, int fq) const {
        const int trow = u.pm * BM; const bool lat = trow < NLAT;
        const float* res = lat ? resL + (size_t)trow * DM : resC + (size_t)(trow - NLAT) * DM;
        float* out = lat ? outL + (size_t)trow * DM : outC + (size_t)(trow - NLAT) * DM;
        const float* g = gate + (size_t)(lat ? (trow >> 12) : 8) * 6144;
        const int col0 = u.pn * BM + wc * 32 + 4 * fq;
#pragma unroll
        for (int bj = 0; bj < 2; ++bj)
#pragma unroll
            for (int n = 0; n < 2; ++n) { const f32x4 gv = *(const f32x4*)(g + col0 + bj * HALF + n * 16);
#pragma unroll
                for (int ai = 0; ai < 2; ++ai)
#pragma unroll
                    for (int m = 0; m < 4; ++m) { const size_t ro = (size_t)(wr * 64 + fr + ai * HALF + m * 16) * DM + col0 + bj * HALF + n * 16;
                        const f32x4 rv = *(const f32x4*)(res + ro);
                        *(f32x4*)(out + ro) = rv + gv * acc[ai][bj][m][n]; } }
    }
};

template <class Epi, class Sched>
__device__ __forceinline__ void gemm_phase(LAS unsigned char* lds, const Gemm g, const Sched& S, const Epi& E, const int tid) {
    const int wid = __builtin_amdgcn_readfirstlane(tid >> 6), lane = tid & 63, wr = wid >> 2, wc = wid & 3, fr = lane & 15, fq = lane >> 4;
    const int K = g.K, nt = K / BK;
    constexpr bool GATHER = Sched::GATHER;
    int RA[2], CA[2]; unsigned voffB[2], voffA[2];
#pragma unroll
    for (int i = 0; i < 2; ++i) { int R, C; stage_rc(tid * 16 + i * 8192, R, C); const int Rb = Epi::PERM ? ((R & ~31) + perm32(R & 31)) : R;
        RA[i] = R; CA[i] = C * 2; voffB[i] = (unsigned)(Rb * K + C) * 2u; voffA[i] = (unsigned)(R * K + C) * 2u; }
    const size_t kstep = (size_t)(BK * 2);
    const size_t hstep = (size_t)HALF * K * 2;
    const unsigned rowb = (unsigned)K * 2u;
    const unsigned ldsw = (unsigned)wid * 1024u;
    const int aoff = lds_byte(wr * 64 + fr, fq * 8), boff = lds_byte(wc * 32 + fr, fq * 8);
#define PG8_SA(b, h) (((b) * 2 + (h)) * HTB)
#define PG8_SB(b, h) ((4 + (b) * 2 + (h)) * HTB)
#define PG8_STAGE(bufoff, gbase, voff) do { _Pragma("unroll") for (int _i = 0; _i < 2; ++_i) \
        __builtin_amdgcn_global_load_lds((const unsigned*)((const char*)(gbase) + (voff)[_i]), (LAS unsigned*)(lds + (bufoff) + ldsw + _i * 8192), 16, 0, 0); } while (0)
#define PG8_LDA(dst, b, h) do { _Pragma("unroll") for (int m = 0; m < 4; ++m) _Pragma("unroll") for (int k = 0; k < 2; ++k) dst[m][k] = *(const LAS bf16x8*)(lds + PG8_SA(b, h) + aoff + m * 2048 + k * 1024); } while (0)
#define PG8_LDB(dst, b, h) do { _Pragma("unroll") for (int n = 0; n < 2; ++n) _Pragma("unroll") for (int k = 0; k < 2; ++k) dst[n][k] = *(const LAS bf16x8*)(lds + PG8_SB(b, h) + boff + n * 2048 + k * 1024); } while (0)
#define PG8_MMA(ai, bj, At, Bt) do { __builtin_amdgcn_s_setprio(1); _Pragma("unroll") for (int m = 0; m < 4; ++m) _Pragma("unroll") for (int n = 0; n < 2; ++n) _Pragma("unroll") for (int k = 0; k < 2; ++k) \
        acc[ai][bj][m][n] = __builtin_amdgcn_mfma_f32_16x16x32_bf16(Bt[n][k], At[m][k], acc[ai][bj][m][n], 0, 0, 0); __builtin_amdgcn_s_setprio(0); } while (0)
#define PG8_WAIT_V(n) asm volatile("s_waitcnt vmcnt(" #n ")" ::: "memory")
#define PG8_WAIT_L(n) asm volatile("s_waitcnt lgkmcnt(" #n ")" ::: "memory")
#define PG8_BAR __builtin_amdgcn_s_barrier()
#define PG8_SCHED __builtin_amdgcn_sched_barrier(0)
#define PG8_STA_CUR(bufoff, ptr, hh) do { if constexpr (GATHER) PG8_STAGE(bufoff, ptr, vAc[hh]); else PG8_STAGE(bufoff, (ptr) + (hh) * hstep, voffA); } while (0)
#define PG8_STA_SEL(bufoff, ptr, hh) do { if constexpr (GATHER) PG8_STAGE(bufoff, ptr, vs[hh]); else PG8_STAGE(bufoff, (ptr) + (hh) * hstep, voffA); } while (0)
#define PG8_MKVOFF(dst, uu) do { _Pragma("unroll") for (int _h = 0; _h < 2; ++_h) _Pragma("unroll") for (int _i = 0; _i < 2; ++_i) \
        dst[_h][_i] = (unsigned)S.a_row(uu, _h * HALF + RA[_i]) * rowb + (unsigned)CA[_i]; } while (0)
    Unit cur, nxt; int ui = 0;
    if (!S.next(0, cur)) return;
    f32x4 acc[2][2][4][2];
#pragma unroll
    for (int a = 0; a < 2; ++a)
#pragma unroll
        for (int b = 0; b < 2; ++b)
#pragma unroll
            for (int m = 0; m < 4; ++m)
#pragma unroll
                for (int n = 0; n < 2; ++n) acc[a][b][m][n] = (f32x4){0.f, 0.f, 0.f, 0.f};
    bf16x8 At[4][2], B0[2][2], B1[2][2];
    unsigned vAc[2][2], vAn[2][2], vs[2][2];
    if constexpr (GATHER) PG8_MKVOFF(vAc, cur);
    const char* cA = (const char*)g.A + (GATHER ? (size_t)0 : (size_t)S.a_row0(cur) * rowb);
    const char* cB = (const char*)g.Bt + (size_t)S.b_row0(cur) * rowb;
    PG8_STAGE(PG8_SB(0, 0), cB, voffB); PG8_STAGE(PG8_SB(0, 1), cB + hstep, voffB); PG8_STA_CUR(PG8_SA(0, 0), cA, 0); PG8_STA_CUR(PG8_SA(0, 1), cA, 1);
    if (wr == 1) PG8_BAR;
    PG8_WAIT_V(2); PG8_BAR;
    PG8_STAGE(PG8_SB(1, 0), cB + kstep, voffB); PG8_STA_CUR(PG8_SA(1, 0), cA + kstep, 0); PG8_STAGE(PG8_SB(1, 1), cB + hstep + kstep, voffB);
    PG8_WAIT_V(6); PG8_BAR;
    for (;;) {
        const bool has_next = S.next(ui + 1, nxt);
        const char* nB = cB; const char* nA = cA;
        if (has_next) { if constexpr (GATHER) PG8_MKVOFF(vAn, nxt); else nA = (const char*)g.A + (size_t)S.a_row0(nxt) * rowb; nB = (const char*)g.Bt + (size_t)S.b_row0(nxt) * rowb; }
        else if constexpr (GATHER) {
#pragma unroll
            for (int h = 0; h < 2; ++h)
#pragma unroll
                for (int i = 0; i < 2; ++i) vAn[h][i] = vAc[h][i];
        }
        for (int t = 0; t < nt; t += 2) {
            const bool last = (t == nt - 2);
            const char* a1 = cA + (size_t)(t + 1) * kstep;
            const char* a2 = last ? nA : cA + (size_t)(t + 2) * kstep; const char* b2 = last ? nB : cB + (size_t)(t + 2) * kstep;
            const char* a3 = a2 + kstep; const char* b3 = b2 + kstep;
            if constexpr (GATHER) {
#pragma unroll
                for (int h = 0; h < 2; ++h)
#pragma unroll
                    for (int i = 0; i < 2; ++i) vs[h][i] = last ? vAn[h][i] : vAc[h][i];
            }
            PG8_LDB(B0, 0, 0); PG8_LDB(B1, 0, 1); PG8_SCHED; PG8_LDA(At, 0, 0); PG8_STA_CUR(PG8_SA(1, 1), a1, 1);
            PG8_WAIT_V(8); PG8_WAIT_L(0); PG8_BAR; PG8_MMA(0, 0, At, B0); PG8_MMA(0, 1, At, B1); PG8_BAR; PG8_SCHED;
            PG8_LDA(At, 0, 1); PG8_STAGE(PG8_SB(0, 0), b2, voffB); PG8_STAGE(PG8_SB(0, 1), b2 + hstep, voffB); PG8_STA_SEL(PG8_SA(0, 0), a2, 0);
            PG8_WAIT_V(8); PG8_WAIT_L(0); PG8_BAR; PG8_MMA(1, 0, At, B0); PG8_MMA(1, 1, At, B1); PG8_BAR; PG8_SCHED;
            PG8_LDB(B0, 1, 0); PG8_LDB(B1, 1, 1); PG8_SCHED; PG8_LDA(At, 1, 0); PG8_STA_SEL(PG8_SA(0, 1), a2, 1);
            PG8_WAIT_V(8); PG8_WAIT_L(0); PG8_BAR; PG8_MMA(0, 0, At, B0); PG8_MMA(0, 1, At, B1); PG8_BAR; PG8_SCHED;
            PG8_LDA(At, 1, 1); PG8_STAGE(PG8_SB(1, 0), b3, voffB); PG8_STAGE(PG8_SB(1, 1), b3 + hstep, voffB); PG8_STA_SEL(PG8_SA(1, 0), a3, 0);
            PG8_WAIT_V(8); PG8_WAIT_L(0); PG8_BAR; PG8_MMA(1, 0, At, B0); PG8_MMA(1, 1, At, B1); PG8_BAR; PG8_SCHED;
        }
        if (wr == 0) PG8_BAR;
        E(acc, cur, wr, wc, fr, fq);
        if (!has_next) break;
#pragma unroll
        for (int a = 0; a < 2; ++a)
#pragma unroll
            for (int b = 0; b < 2; ++b)
#pragma unroll
                for (int m = 0; m < 4; ++m)
#pragma unroll
                    for (int n = 0; n < 2; ++n) acc[a][b][m][n] = (f32x4){0.f, 0.f, 0.f, 0.f};
        cur = nxt; cB = nB; cA = nA; ++ui;
        if constexpr (GATHER) {
#pragma unroll
            for (int h = 0; h < 2; ++h)
#pragma unroll
                for (int i = 0; i < 2; ++i) vAc[h][i] = vAn[h][i];
        }
        if (wr == 1) PG8_BAR;
    }
    PG8_WAIT_V(0);
    PG8_BAR;
#undef PG8_SA
#undef PG8_SB
#undef PG8_STAGE
#undef PG8_LDA
#undef PG8_LDB
#undef PG8_MMA
#undef PG8_WAIT_V
#undef PG8_WAIT_L
#undef PG8_BAR
#undef PG8_SCHED
#undef PG8_MKVOFF
#undef PG8_STA_CUR
#undef PG8_STA_SEL
}
}

struct Frame {
    LAS unsigned char* lds;
    int tid, lane, wave, G, bid;
    const float* const __attribute__((address_space(4)))* in;
    float* out; unsigned char* ws;
};
#define IN_X 0
#define IN_C 1
#define IN_CTX 2
#define IN_CCTX 3
#define IN_ADAW 4
#define IN_ADAB 5
#define IN_N1G 6
#define IN_N2G 7
#define IN_WIN 8
#define IN_WOUT 9
#define IN_CONVW 10
#define IN_RETDEC 11
#define IN_ALOG 12
#define IN_DTB 13
#define IN_GNG 14
#define IN_RPB 15
#define IN_FW1 16
#define IN_FW3 17
#define IN_FW2 18
#define IN_ROUTER 19
#define IN_MW1 20
#define IN_MW3 21
#define IN_MW2 22
#define IN_FINALG 23

__device__ __forceinline__ const float* mod_vec(const Frame& F, int l, int row, int slot) {
    const int j = row < NLAT ? (row >> 12) : 8;
    return (const float*)(F.ws + WS_MOD) + ((size_t)(l * 9 + j) * 6 + slot) * 1024;
}

__device__ __forceinline__ int dst_row(int kind, int n) {
    if (kind == 1) return n < 2048 ? n : (n < 2064 ? 3584 + (n - 2048) : n - 16);
    if (kind == 2) return 256 * (n >> 7) + (n & 127);
    if (kind == 3) return 256 * (n >> 7) + 128 + (n & 127);
    return n;
}
__device__ __forceinline__ void transpose_item(const float* W, int K, int N, bf16* WT, int kind, LAS float* scr, int item, int lane) {
    const int nblk = (N + 31) / 32, kb = item / nblk, nb = item % nblk, k0 = 64 * kb, n0 = 32 * nb;
    const bool nok = (n0 + (lane & 31)) < N;
#pragma unroll 8
    for (int i = 0; i < 32; ++i) { const int kk = 2 * i + (lane >> 5); scr[kk * 33 + (lane & 31)] = nok ? W[(size_t)(k0 + kk) * N + n0 + (lane & 31)] : 0.f; }
    asm volatile("s_waitcnt lgkmcnt(0)" ::: "memory");
    const int c = lane & 7;
#pragma unroll
    for (int j = 0; j < 4; ++j) { const int n = (lane >> 3) + 8 * j; const LAS float* s = scr + (8 * c) * 33 + n;
        u32x4 o; o.x = pk2(s[0 * 33], s[1 * 33]); o.y = pk2(s[2 * 33], s[3 * 33]); o.z = pk2(s[4 * 33], s[5 * 33]); o.w = pk2(s[6 * 33], s[7 * 33]);
        if (n0 + n < N) *(u32x4*)(WT + (size_t)dst_row(kind, n0 + n) * K + k0 + 8 * c) = o; }
    asm volatile("s_waitcnt lgkmcnt(0)" ::: "memory");
}

__device__ __forceinline__ void sincos_d(double x, float& c, float& s) {
    const double n = rint(x * 0.63661977236758134308), r = (x - n * 1.57079632679489655800) - n * 6.123233995736766036e-17;
    const double r2 = r * r;
    double sp = r * (1.0 + r2 * (-1.0 / 6 + r2 * (1.0 / 120 + r2 * (-1.0 / 5040 + r2 * (1.0 / 362880 + r2 * (-1.0 / 39916800 + r2 * (1.0 / 6227020800.0)))))));
    double cp = 1.0 + r2 * (-0.5 + r2 * (1.0 / 24 + r2 * (-1.0 / 720 + r2 * (1.0 / 40320 + r2 * (-1.0 / 3628800 + r2 * (1.0 / 479001600.0 + r2 * (-1.0 / 87178291200.0)))))));
    const int q = ((int)n) & 3;
    const double ss = (q == 0) ? sp : (q == 1) ? cp : (q == 2) ? -sp : -cp;
    const double cc = (q == 0) ? cp : (q == 1) ? -sp : (q == 2) ? -cp : sp;
    c = (float)cc; s = (float)ss;
}

__device__ __forceinline__ void phase_prologue(Frame& F) {
    for (int it = F.bid; it < 192; it += F.G) {
        const int l = it / 96, cb = it % 96, n = cb * 64 + F.lane;
        LAS float* SV = (LAS float*)F.lds;
        LAS float* RED = SV + 9 * 1024;
        for (int i = F.tid; i < 9 * 1024; i += NTHR) { const int j = i >> 10, k = i & 1023; const float v = j < 8 ? F.in[IN_C][j * 1024 + k] : F.in[IN_CCTX][k]; SV[i] = silu_f(v); }
        __syncthreads();
        float a[9];
#pragma unroll
        for (int j = 0; j < 9; ++j) a[j] = 0.f;
        const float* W = F.in[IN_ADAW] + (size_t)l * 1024 * 6144 + n;
        const int k0 = F.wave * 128;
#pragma unroll 8
        for (int k = 0; k < 128; ++k) { const float w = W[(size_t)(k0 + k) * 6144];
#pragma unroll
            for (int j = 0; j < 9; ++j) a[j] += w * SV[j * 1024 + k0 + k]; }
#pragma unroll
        for (int j = 0; j < 9; ++j) RED[(F.wave * 9 + j) * 64 + F.lane] = a[j];
        __syncthreads();
        for (int i = F.tid; i < 9 * 64; i += NTHR) { const int j = i >> 6, c = i & 63; float s = F.in[IN_ADAB][l * 6144 + cb * 64 + c];
#pragma unroll
            for (int w = 0; w < 8; ++w) s += RED[(w * 9 + j) * 64 + c];
            ((float*)(F.ws + WS_MOD))[(size_t)(l * 9 + j) * 6144 + cb * 64 + c] = s; }
        __syncthreads();
    }
    if (F.bid == F.G - 1) {
        for (int i = F.tid; i < 1024; i += NTHR) { const int pos = i >> 4, f = i & 15;
            const float invf = (float)exp2(-(double)f / 16.0 * 13.287712379549449);
            float c, s; sincos_d((double)((float)pos * invf), c, s);
            ((f32x2*)(F.ws + WS_ROPE))[i] = (f32x2){c, s}; }
    }
    LAS float* scr = (LAS float*)(F.lds + F.wave * 8448);
    __syncthreads();
    const int gw = F.bid * NWAVES + F.wave, NGW = F.G * NWAVES;
    constexpr int I_IN = 16 * 113, I_OUT = 16 * 32, I_FF = 16 * 88, I_F2 = 44 * 32;
    constexpr int NIT = 2 * I_IN + 2 * I_OUT + 2 * I_FF + I_F2;
    for (int it = gw; it < NIT; it += NGW) {
        int r = it;
        if (r < 2 * I_IN) { const int l = r / I_IN; transpose_item(F.in[IN_WIN] + (size_t)l * DM * NINSRC, DM, NINSRC, (bf16*)(F.ws + WS_WIN) + (size_t)l * NIN * DM, 1, scr, r % I_IN, F.lane); continue; } r -= 2 * I_IN;
        if (r < 2 * I_OUT) { const int l = r / I_OUT; transpose_item(F.in[IN_WOUT] + (size_t)l * DM * DM, DM, DM, (bf16*)(F.ws + WS_WOUT) + (size_t)l * DM * DM, 0, scr, r % I_OUT, F.lane); continue; } r -= 2 * I_OUT;
        if (r < I_FF) { transpose_item(F.in[IN_FW1], DM, DFF, (bf16*)(F.ws + WS_W13D), 2, scr, r, F.lane); continue; } r -= I_FF;
        if (r < I_FF) { transpose_item(F.in[IN_FW3], DM, DFF, (bf16*)(F.ws + WS_W13D), 3, scr, r, F.lane); continue; } r -= I_FF;
        transpose_item(F.in[IN_FW2], DFF, DM, (bf16*)(F.ws + WS_W2D), 0, scr, r, F.lane);
    }
    for (int i = F.bid * NTHR + F.tid; i < 2 * 240 * 128; i += F.G * NTHR) { const int l = i / (240 * 128), r = (i / 128) % 240, c = i % 128;
        *(u32x4*)((bf16*)(F.ws + WS_WIN) + ((size_t)l * NIN + 3600 + r) * DM + c * 8) = (u32x4){0u, 0u, 0u, 0u}; }
}
__device__ __forceinline__ void moe_weight_copy(Frame& F) {
    LAS float* scr = (LAS float*)(F.lds + F.wave * 8448);
    const int gw = F.bid * NWAVES + F.wave, NGW = F.G * NWAVES;
    constexpr int I_FF = 16 * 88, I_F2 = 44 * 32, PER_E = 2 * I_FF + I_F2;
    for (int it = gw; it < NEXP * PER_E; it += NGW) {
        const int e = it / PER_E; int r = it % PER_E;
        bf16* w13 = (bf16*)(F.ws + WS_MW13) + (size_t)e * 2 * DFF * DM; bf16* w2 = (bf16*)(F.ws + WS_MW2) + (size_t)e * DM * DFF;
        const size_t eo = (size_t)e * DM * DFF;
        if (r < I_FF) { transpose_item(F.in[IN_MW1] + eo, DM, DFF, w13, 2, scr, r, F.lane); continue; } r -= I_FF;
        if (r < I_FF) { transpose_item(F.in[IN_MW3] + eo, DM, DFF, w13, 3, scr, r, F.lane); continue; } r -= I_FF;
        transpose_item(F.in[IN_MW2] + eo, DFF, DM, w2, 0, scr, r, F.lane);
    }
}

__device__ __forceinline__ void norm_row(const Frame& F, const float* xrow, const float* g, const float* shift, const float* scale, bf16* orow, f32x4 (&hv)[4]) {
    const f32x4* xr = (const f32x4*)xrow + F.lane;
    f32x4 v[4]; float s = 0.f;
#pragma unroll
    for (int j = 0; j < 4; ++j) { v[j] = xr[64 * j]; s += (v[j].x * v[j].x + v[j].y * v[j].y) + (v[j].z * v[j].z + v[j].w * v[j].w); }
    const float rstd = 1.0f / sqrtf(wave_sum(s) * (1.f / DM) + EPSF);
#pragma unroll
    for (int j = 0; j < 4; ++j) {
        const f32x4 gg = ((const f32x4*)g)[F.lane + 64 * j], sh = ((const f32x4*)shift)[F.lane + 64 * j], sc = ((const f32x4*)scale)[F.lane + 64 * j];
        hv[j] = (v[j] * rstd * gg) * (sc + 1.0f) + sh;
        u32x2 o; o.x = pk2(hv[j].x, hv[j].y); o.y = pk2(hv[j].z, hv[j].w);
        *((u32x2*)orow + F.lane + 64 * j) = o;
    }
}
__device__ __forceinline__ void phase_norm(Frame& F, int l, int which  , const float* xl, const float* xc, int nrows) {
    const float* g = F.in[which ? IN_N2G : IN_N1G] + l * 1024;
    const int gw = F.bid * NWAVES + F.wave, NGW = F.G * NWAVES;
    for (int row = gw; row < nrows; row += NGW) {
        const float* xrow = row < NLAT ? xl + (size_t)row * DM : xc + (size_t)(row - NLAT) * DM;
        f32x4 hv[4];
        norm_row(F, xrow, g, mod_vec(F, l, row, which ? 3 : 0), mod_vec(F, l, row, which ? 4 : 1), (bf16*)(F.ws + WS_HM) + (size_t)row * DM, hv);
    }
}
__device__ __forceinline__ void phase_norm_route(Frame& F, int l, const float* xl) {
    const float* g = F.in[IN_N2G] + l * 1024;
    LAS float* WR = (LAS float*)F.lds;
    LAS int* RE = (LAS int*)(F.lds + 32768);
    LAS float* RG = (LAS float*)(F.lds + 32768 + 1024);
    LAS int* LC = (LAS int*)(F.lds + 32768 + 2048);
    LAS int* RK = (LAS int*)(F.lds + 32768 + 2048 + 64);
    for (int i = F.tid; i < 8192; i += NTHR) WR[i] = F.in[IN_ROUTER][i];
    unsigned* gcnt = (unsigned*)(F.ws + WS_CTL) + CW_CNT;
    int* tokslot = (int*)(F.ws + WS_TOKSLOT);
    for (int blk = F.bid; blk < NLAT / 128; blk += F.G) {
        if (F.tid < 16) LC[F.tid] = 0;
        __syncthreads();
        for (int rr = 0; rr < 16; ++rr) {
            const int lr = F.wave * 16 + rr, row = blk * 128 + lr;
            f32x4 hv[4];
            norm_row(F, xl + (size_t)row * DM, g, mod_vec(F, l, row, 3), mod_vec(F, l, row, 4), (bf16*)(F.ws + WS_HM) + (size_t)row * DM, hv);
            float lg[8];
#pragma unroll
            for (int e = 0; e < 8; ++e) lg[e] = 0.f;
#pragma unroll
            for (int j = 0; j < 4; ++j)
#pragma unroll
                for (int c = 0; c < 4; ++c) { const int k = 4 * (F.lane + 64 * j) + c; const float hval = hv[j][c];
                    const f32x4 w0 = *(const LAS f32x4*)(WR + k * 8), w1 = *(const LAS f32x4*)(WR + k * 8 + 4);
                    lg[0] += hval * w0.x; lg[1] += hval * w0.y; lg[2] += hval * w0.z; lg[3] += hval * w0.w;
                    lg[4] += hval * w1.x; lg[5] += hval * w1.y; lg[6] += hval * w1.z; lg[7] += hval * w1.w; }
#pragma unroll
            for (int e = 0; e < 8; ++e) lg[e] = wave_sum(lg[e]);
            if (F.lane == 0) {
                int e0 = 0; float v0 = lg[0];
#pragma unroll
                for (int e = 1; e < 8; ++e) if (lg[e] > v0) { v0 = lg[e]; e0 = e; }
                int e1 = -1; float v1 = -3.0e38f;
#pragma unroll
                for (int e = 0; e < 8; ++e) if (e != e0 && lg[e] > v1) { v1 = lg[e]; e1 = e; }
                const float g1 = 1.f / (1.f + __expf(v0 - v1)), g0 = 1.f - g1;
                RE[lr * 2] = e0; RE[lr * 2 + 1] = e1; RG[lr * 2] = g0; RG[lr * 2 + 1] = g1;
            }
        }
        __syncthreads();
        if (F.tid < 256) { const int e = RE[F.tid]; RK[F.tid] = atomicAdd((int*)&LC[e], 1); }
        __syncthreads();
        if (F.tid < 8) LC[8 + F.tid] = (int)__hip_atomic_fetch_add(gcnt + F.tid, (unsigned)LC[F.tid], __ATOMIC_RELAXED, __HIP_MEMORY_SCOPE_AGENT);
        __syncthreads();
        if (F.tid < 128) {
            const int row = blk * 128 + F.tid;
            const int e0 = RE[F.tid * 2], e1 = RE[F.tid * 2 + 1];
            const int p0 = LC[8 + e0] + RK[F.tid * 2], p1 = LC[8 + e1] + RK[F.tid * 2 + 1];
            tokslot[e0 * 32768 + p0] = row; tokslot[e1 * 32768 + p1] = row;
            u32x4 a; a.x = (unsigned)e0; a.y = (unsigned)p0; a.z = (unsigned)e1; a.w = (unsigned)p1;
            u32x4 b; b.x = __float_as_uint(RG[F.tid * 2]); b.y = __float_as_uint(RG[F.tid * 2 + 1]); b.z = 0u; b.w = 0u;
            u32x4* ri = (u32x4*)(F.ws + WS_RINFO) + (size_t)row * 2; ri[0] = a; ri[1] = b;
        }
        __syncthreads();
    }
}

__device__ __forceinline__ void phase_final(Frame& F) {
    const unsigned* gcnt = (const unsigned*)(F.ws + WS_CTL) + CW_CNT;
    int ts[8]; { int acc = 0;
#pragma unroll
        for (int e = 0; e < 8; ++e) { ts[e] = acc; acc += ((int)gcnt[e] + 255) >> 8; } }
    const bf16* Y = (const bf16*)(F.ws + WS_Y);
    const int gw = F.bid * NWAVES + F.wave, NGW = F.G * NWAVES;
    for (int row = gw; row < NLAT; row += NGW) {
        const u32x4* ri = (const u32x4*)(F.ws + WS_RINFO) + (size_t)row * 2; const u32x4 a = ri[0], b = ri[1];
        int t0 = 0, t1 = 0;
#pragma unroll
        for (int e = 0; e < 8; ++e) { t0 = ((int)a.x == e) ? ts[e] : t0; t1 = ((int)a.z == e) ? ts[e] : t1; }
        const bf16* y0 = Y + (size_t)(t0 * 256 + (int)a.y) * DM; const bf16* y1 = Y + (size_t)(t1 * 256 + (int)a.w) * DM;
        const float g0 = __uint_as_float(b.x), g1 = __uint_as_float(b.y);
        const float* gate = mod_vec(F, 1, row, 5);
        f32x4* xr = (f32x4*)(F.out + (size_t)row * DM) + F.lane;
        f32x4 v[4]; float s = 0.f;
#pragma unroll
        for (int j = 0; j < 4; ++j) {
            const u32x2 w0 = *((const u32x2*)y0 + F.lane + 64 * j), w1 = *((const u32x2*)y1 + F.lane + 64 * j);
            f32x4 a0, a1;
            a0.x = __uint_as_float(w0.x << 16); a0.y = __uint_as_float(w0.x & 0xffff0000u); a0.z = __uint_as_float(w0.y << 16); a0.w = __uint_as_float(w0.y & 0xffff0000u);
            a1.x = __uint_as_float(w1.x << 16); a1.y = __uint_as_float(w1.x & 0xffff0000u); a1.z = __uint_as_float(w1.y << 16); a1.w = __uint_as_float(w1.y & 0xffff0000u);
            const f32x4 gt = ((const f32x4*)gate)[F.lane + 64 * j];
            v[j] = xr[64 * j] + gt * (a0 * g0 + a1 * g1);
            s += (v[j].x * v[j].x + v[j].y * v[j].y) + (v[j].z * v[j].z + v[j].w * v[j].w);
        }
        const float rstd = 1.0f / sqrtf(wave_sum(s) * (1.f / DM) + EPSF);
#pragma unroll
        for (int j = 0; j < 4; ++j) xr[64 * j] = v[j] * rstd * ((const f32x4*)F.in[IN_FINALG])[F.lane + 64 * j];
    }
}

__device__ __forceinline__ float ret_lg(const Frame& F, int l, int dir, int h) { return log1pf(-exp2f(-F.in[IN_RETDEC][(l * 2 + dir) * 4 + h])); }
__device__ __forceinline__ int ret_row(int b, int c, int j) { return c < 2 ? NLAT + b * CTXL + c * 128 + j : b * SEQ + (c - 2) * 128 + j; }
__device__ __forceinline__ int gdn_row(int b, int c, int j) { return c < 4 ? NLAT + b * CTXL + c * 64 + j : b * SEQ + (c - 4) * 64 + j; }

__device__ __forceinline__ void ret_load(const Frame& F, LAS float* dst, int pitch, int b, int c, int col0, bool rope, float scl) {
    const bf16* PA = (const bf16*)(F.ws + WS_PA); const f32x2* RT = (const f32x2*)(F.ws + WS_ROPE);
    for (int i = F.tid; i < 128 * 32; i += NTHR) { const int j = i >> 5, p = i & 31; const int row = ret_row(b, c, j);
        const float x1 = bf2f(PA[(size_t)row * 2048 + col0 + p]), x2 = bf2f(PA[(size_t)row * 2048 + col0 + 32 + p]);
        float o1 = x1, o2 = x2;
        if (rope && c >= 2) { const int t = (c - 2) * 128 + j; const int pos = p < 16 ? (t >> 6) : (t & 63); const f32x2 cs = RT[pos * 16 + (p & 15)];
            o1 = x1 * cs.x - x2 * cs.y; o2 = x1 * cs.y + x2 * cs.x; }
        dst[j * pitch + p] = o1 * scl; dst[j * pitch + 32 + p] = o2 * scl; }
}
__device__ __forceinline__ void phase_R1(Frame& F, int l) {
    LAS float* kf = (LAS float*)F.lds; LAS float* vf = kf + 128 * 64; LAS float* wt = vf + 128 * 64;
    float* RS = (float*)(F.ws + WS_RS);
    for (int u = F.bid; u < 32 * 34; u += F.G) {
        const int bh = u / 34, c = u % 34, b = bh >> 2, h = bh & 3;
        ret_load(F, kf, 64, b, c, 256 + h * 64, true, 0.125f);
        ret_load(F, vf, 64, b, c, 512 + h * 64, false, 1.f);
        if (F.tid < 256) { const int dir = F.tid >> 7, j = F.tid & 127; wt[F.tid] = __expf(ret_lg(F, l, dir, h) * (float)(dir ? j : 127 - j)); }
        __syncthreads();
#pragma unroll 1
        for (int r = 0; r < 16; ++r) { const int o = F.tid + NTHR * r, dir = o >> 12, dk = (o >> 6) & 63, dv = o & 63;
            float s = 0.f;
            for (int j = 0; j < 128; ++j) s += kf[j * 64 + dk] * wt[dir * 128 + j] * vf[j * 64 + dv];
            RS[(((size_t)bh * 2 + dir) * 34 + c) * 4096 + dk * 64 + dv] = s; }
        __syncthreads();
    }
}
__device__ __forceinline__ void phase_R2(Frame& F, int l) {
    float* RS = (float*)(F.ws + WS_RS);
    for (int it = F.bid; it < 256; it += F.G) {
        const int seq = it >> 2, bh = seq >> 1, dir = seq & 1, h = bh & 3;
        const float cd = __expf(ret_lg(F, l, dir, h) * 128.f);
        f32x2* base = (f32x2*)(RS + (size_t)seq * 34 * 4096) + (it & 3) * 512 + F.tid;
        f32x2 s = (f32x2){0.f, 0.f};
        for (int st = 0; st < 34; ++st) { const int c = dir == 0 ? st : (st < 2 ? 1 - st : 35 - st);
            f32x2* p = base + (size_t)c * 2048; const f32x2 d = *p; *p = s; s = s * cd + d; }
    }
}
__device__ __forceinline__ void phase_R3(Frame& F, int l) {
    LAS float* qf = (LAS float*)F.lds; LAS float* kf = qf + 128 * 65; LAS float* vf = kf + 128 * 65; LAS float* sc = vf + 128 * 64;
    const float* RS = (const float*)(F.ws + WS_RS); const bf16* PA = (const bf16*)(F.ws + WS_PA); bf16* MIX = (bf16*)(F.ws + WS_HM);
    const int c_lo = (l == 1) ? 2 : 0;
    const int nch = 34 - c_lo;
    for (int u = F.bid; u < 32 * nch; u += F.G) {
        const int bh = u / nch, c = c_lo + u % nch, b = bh >> 2, h = bh & 3;
        const float lf = ret_lg(F, l, 0, h), lb = ret_lg(F, l, 1, h);
        ret_load(F, qf, 65, b, c, 0 + h * 64, true, 1.f);
        ret_load(F, kf, 65, b, c, 256 + h * 64, true, 0.125f);
        ret_load(F, vf, 64, b, c, 512 + h * 64, false, 1.f);
        __syncthreads();
        const float* Sf = RS + (((size_t)bh * 2 + 0) * 34 + c) * 4096; const float* Sb = RS + (((size_t)bh * 2 + 1) * 34 + c) * 4096;
        const int hr = F.tid >> 3, s8 = F.tid & 7;
#pragma unroll 1
        for (int half = 0; half < 2; ++half) {
            const int n = half * 64 + hr;
#pragma unroll 1
            for (int mm = 0; mm < 16; ++mm) { const int m = s8 + 8 * mm; float s = 0.f;
                for (int d = 0; d < 64; ++d) s += qf[n * 65 + d] * kf[m * 65 + d];
                const int df = n - m; float D = 0.f; if (df >= 0) D += __expf(lf * (float)df); if (df <= 0) D += __expf(lb * (float)(-df));
                sc[hr * 128 + m] = s * D; }
            __syncthreads();
            float o[8];
#pragma unroll
            for (int e = 0; e < 8; ++e) o[e] = 0.f;
            for (int m = 0; m < 128; ++m) { const float p = sc[hr * 128 + m];
#pragma unroll
                for (int e = 0; e < 8; ++e) o[e] += p * vf[m * 64 + s8 * 8 + e]; }
            const float qdf = __expf(lf * (float)(n + 1)), qdb = __expf(lb * (float)(128 - n));
            for (int dk = 0; dk < 64; ++dk) { const float q = qf[n * 65 + dk];
                const f32x4 a0 = *(const f32x4*)(Sf + dk * 64 + s8 * 8), a1 = *(const f32x4*)(Sf + dk * 64 + s8 * 8 + 4);
                const f32x4 b0 = *(const f32x4*)(Sb + dk * 64 + s8 * 8), b1 = *(const f32x4*)(Sb + dk * 64 + s8 * 8 + 4);
                const float qa = q * qdf, qb = q * qdb;
                o[0] += qa * a0.x + qb * b0.x; o[1] += qa * a0.y + qb * b0.y; o[2] += qa * a0.z + qb * b0.z; o[3] += qa * a0.w + qb * b0.w;
                o[4] += qa * a1.x + qb * b1.x; o[5] += qa * a1.y + qb * b1.y; o[6] += qa * a1.z + qb * b1.z; o[7] += qa * a1.w + qb * b1.w; }
            float ss = 0.f;
#pragma unroll
            for (int e = 0; e < 8; ++e) ss += o[e] * o[e];
            ss += __shfl_xor(ss, 1); ss += __shfl_xor(ss, 2); ss += __shfl_xor(ss, 4);
            const float rr = 1.0f / sqrtf(ss * (1.f / 64.f) + EPSF);
            const int row = ret_row(b, c, n);
            float gt[8]; load8bf(PA + (size_t)row * 2048 + 768 + h * 64 + s8 * 8, gt);
#pragma unroll
            for (int e = 0; e < 8; ++e) o[e] = o[e] * rr * silu_f(gt[e]);
            store8bf(MIX + (size_t)row * DM + h * 64 + s8 * 8, o);
            __syncthreads();
        }
    }
}

__device__ __forceinline__ void phase_NA(Frame& F, int l) {
    LAS float* sc = (LAS float*)F.lds;
    LAS float* qs = sc + 64 * 388;
    LAS float* rp = qs + 64 * 65;
    const bf16* PB = (const bf16*)(F.ws + WS_PB); bf16* MIX = (bf16*)(F.ws + WS_HM);
    const int n_lat = NB * 8 * 64, n_ctx = (l == 0) ? NB * 8 * 4 : 0;
    for (int u = F.bid; u < n_lat + n_ctx; u += F.G) {
        const bool isl = u < n_lat;
        int b, h, r, qrow0, nkeys;
        if (isl) { b = u >> 9; h = (u >> 6) & 7; r = u & 63; qrow0 = b * SEQ + r * 64; nkeys = 384; }
        else { const int v = u - n_lat; b = v >> 5; h = (v >> 2) & 7; r = v & 3; qrow0 = NLAT + b * CTXL + r * 64; nkeys = 256; }
        const int r0 = min(max(r - 4, 0), 56);
        for (int i = F.tid; i < 64 * 64; i += NTHR) { const int q = i >> 6, d = i & 63; qs[q * 65 + d] = bf2f(PB[(size_t)(qrow0 + q) * 1536 + h * 64 + d]); }
        for (int i = F.tid; i < 465; i += NTHR) rp[i] = F.in[IN_RPB][(size_t)(l * 8 + h) * 465 + i];
        __syncthreads();
        const int qc = F.tid >> 3, s8 = F.tid & 7;
        const int ws = min(max(qc - 8, 0), 48);
        const int ctx0 = NLAT + b * CTXL;
        float mx = -3.0e38f;
        const int nper = nkeys >> 3;
#pragma unroll 1
        for (int ee = 0; ee < nper; ++ee) { const int e = s8 + 8 * ee;
            int krow; float bias = 0.f;
            if (isl && e < 128) { const int i = e >> 4, kcol = ws + (e & 15); krow = b * SEQ + (r0 + i) * 64 + kcol; bias = rp[(r0 + i - r + 7) * 31 + (kcol - qc + 15)]; }
            else krow = ctx0 + (isl ? e - 128 : e);
            const bf16* kp = PB + (size_t)krow * 1536 + 512 + h * 64; float s = 0.f;
#pragma unroll
            for (int d8 = 0; d8 < 8; ++d8) { float kv[8]; load8bf(kp + d8 * 8, kv);
#pragma unroll
                for (int j = 0; j < 8; ++j) s += kv[j] * qs[qc * 65 + d8 * 8 + j]; }
            s = s * 0.125f + bias; sc[qc * 388 + e] = s; mx = fmaxf(mx, s); }
        mx = fmaxf(mx, __shfl_xor(mx, 1)); mx = fmaxf(mx, __shfl_xor(mx, 2)); mx = fmaxf(mx, __shfl_xor(mx, 4));
        float sum = 0.f;
#pragma unroll 1
        for (int ee = 0; ee < nper; ++ee) { const int e = s8 + 8 * ee; const float p = __expf(sc[qc * 388 + e] - mx); sc[qc * 388 + e] = p; sum += p; }
        sum += __shfl_xor(sum, 1); sum += __shfl_xor(sum, 2); sum += __shfl_xor(sum, 4);
        __syncthreads();
        float o[8];
#pragma unroll
        for (int j = 0; j < 8; ++j) o[j] = 0.f;
#pragma unroll 1
        for (int e = 0; e < nkeys; ++e) {
            int krow;
            if (isl && e < 128) { const int i = e >> 4, kcol = ws + (e & 15); krow = b * SEQ + (r0 + i) * 64 + kcol; }
            else krow = ctx0 + (isl ? e - 128 : e);
            float vv[8]; load8bf(PB + (size_t)krow * 1536 + 1024 + h * 64 + s8 * 8, vv);
            const float p = sc[qc * 388 + e];
#pragma unroll
            for (int j = 0; j < 8; ++j) o[j] += p * vv[j]; }
        const float inv = 1.f / sum;
#pragma unroll
        for (int j = 0; j < 8; ++j) o[j] *= inv;
        store8bf(MIX + (size_t)(qrow0 + qc) * DM + 512 + h * 64 + s8 * 8, o);
        __syncthreads();
    }
}

__device__ __forceinline__ void gdn_conv(const Frame& F, int l, LAS float* dst, int pitch, int b, int h, int c, int which) {
    const bf16* PA = (const bf16*)(F.ws + WS_PA);
    const int d = F.tid & 63, t0 = (F.tid >> 6) * 8;
    const int col = 1024 + which * 256 + h * 64 + d;
    float w[5];
#pragma unroll
    for (int j = 0; j < 5; ++j) w[j] = F.in[IN_CONVW][(size_t)(l * 5 + j) * 768 + which * 256 + h * 64 + d];
    const bool isc = c < 4; const int len = isc ? CTXL : SEQ; const int tb = isc ? c * 64 : (c - 4) * 64; const int rowb = isc ? NLAT + b * CTXL : b * SEQ;
    float x[12];
#pragma unroll
    for (int j = 0; j < 12; ++j) { const int t = tb + t0 + j - 2; x[j] = (t >= 0 && t < len) ? bf2f(PA[(size_t)(rowb + t) * 2048 + col]) : 0.f; }
#pragma unroll
    for (int j = 0; j < 8; ++j) { float y = 0.f;
#pragma unroll
        for (int k = 0; k < 5; ++k) y += x[j + k] * w[k];
        dst[(t0 + j) * pitch + d] = silu_f(y); }
}
__device__ __forceinline__ void l2norm_rows(const Frame& F, LAS float* x, int pitch, float scl) {
    const int r = F.tid >> 3, s8 = F.tid & 7; float s = 0.f;
#pragma unroll
    for (int j = 0; j < 8; ++j) { const float v = x[r * pitch + s8 + 8 * j]; s += v * v; }
    s += __shfl_xor(s, 1); s += __shfl_xor(s, 2); s += __shfl_xor(s, 4);
    const float f = scl / sqrtf(s + EPSF);
#pragma unroll
    for (int j = 0; j < 8; ++j) x[r * pitch + s8 + 8 * j] *= f;
}
__device__ __forceinline__ void phase_G1(Frame& F, int l) {
    LAS float* kf = (LAS float*)F.lds; LAS float* vf = kf + 64 * 65; LAS float* Am = vf + 64 * 65;
    LAS float* sol = Am + 2 * 64 * 65;
    LAS float* gcl = sol + 2 * 64 * 128;
    LAS float* btl = gcl + 128;
    const bf16* PC = (const bf16*)(F.ws + WS_PC);
    bf16* GW = (bf16*)(F.ws + WS_GW); bf16* GU = (bf16*)(F.ws + WS_GU); bf16* GK = (bf16*)(F.ws + WS_GK);
    float* GC = (float*)(F.ws + WS_GC); float* GD = (float*)(F.ws + WS_GD);
    for (int u = F.bid; u < 32 * 68; u += F.G) {
        const int bh = u / 68, c = u % 68, b = bh >> 2, h = bh & 3;
        gdn_conv(F, l, kf, 65, b, h, c, 1);
        gdn_conv(F, l, vf, 65, b, h, c, 2);
        if (F.tid < 128) { const int dir = F.tid >> 6, pos = F.tid & 63; const int row = gdn_row(b, c, pos);
            const float a = bf2f(PC[(size_t)row * 256 + dir * 4 + h]), bb = bf2f(PC[(size_t)row * 256 + 8 + dir * 4 + h]);
            const float z = a + F.in[IN_DTB][(l * 2 + dir) * 4 + h];
            const float sp = z > 20.f ? z : log1pf(__expf(z));
            gcl[F.tid] = -__expf(F.in[IN_ALOG][(l * 2 + dir) * 4 + h]) * sp;
            btl[F.tid] = 1.f / (1.f + __expf(-bb)); }
        __syncthreads();
        l2norm_rows(F, kf, 65, 1.f);
        if (F.tid < 2) { const int dir = F.tid; float s = 0.f;
            if (dir == 0) { for (int p = 0; p < 64; ++p) { s += gcl[p]; gcl[p] = s; } }
            else { for (int p = 63; p >= 0; --p) { s += gcl[64 + p]; gcl[64 + p] = s; } } }
        __syncthreads();
#pragma unroll 1
        for (int r = 0; r < 8; ++r) { const int o = F.tid + NTHR * r, i = o >> 6, j = o & 63; float s = 0.f;
            for (int d = 0; d < 64; ++d) s += kf[i * 65 + d] * kf[j * 65 + d];
            Am[i * 65 + j] = (i > j) ? btl[i] * s * __expf(gcl[i] - gcl[j]) : 0.f;
            Am[64 * 65 + i * 65 + j] = (i < j) ? btl[64 + i] * s * __expf(gcl[64 + i] - gcl[64 + j]) : 0.f; }
        __syncthreads();
        if (F.tid < 256) {
            const int dir = F.tid >> 7, col = F.tid & 127; LAS float* so = sol + dir * 64 * 128; const LAS float* A = Am + dir * 64 * 65;
#pragma unroll 1
            for (int st = 0; st < 64; ++st) { const int i = dir ? 63 - st : st;
                float v = (col < 64) ? vf[i * 65 + col] * btl[dir * 64 + i] : kf[i * 65 + col - 64] * btl[dir * 64 + i] * __expf(gcl[dir * 64 + i]);
                for (int s2 = 0; s2 < st; ++s2) { const int j = dir ? 63 - s2 : s2; v -= A[i * 65 + j] * so[j * 128 + col]; }
                so[i * 128 + col] = v; }
            const int seq = bh * 2 + dir; const size_t cb = ((size_t)seq * 68 + c) * 4096;
            if (col < 64) { for (int p = 0; p < 64; ++p) GU[cb + p * 64 + col] = (bf16)f2bf(so[p * 128 + col]); }
            else { for (int p = 0; p < 64; ++p) GW[cb + p * 64 + col - 64] = (bf16)f2bf(so[p * 128 + col]); }
        }
        for (int i = F.tid; i < 2 * 4096; i += NTHR) { const int dir = i >> 12, dk = (i >> 6) & 63, pos = i & 63;
            const float gl = dir ? gcl[64] : gcl[63];
            GK[((size_t)(bh * 2 + dir) * 68 + c) * 4096 + dk * 64 + pos] = (bf16)f2bf(kf[pos * 65 + dk] * __expf(gl - gcl[dir * 64 + pos])); }
        if (F.tid < 128) { const int dir = F.tid >> 6, pos = F.tid & 63; GC[((size_t)(bh * 2 + dir) * 68 + c) * 64 + pos] = gcl[F.tid];
            if (pos == 0) GD[(bh * 2 + dir) * 68 + c] = __expf(dir ? gcl[64] : gcl[63]); }
        __syncthreads();
    }
}
__device__ __forceinline__ void phase_G2(Frame& F, int l) {
    LAS float* ST = (LAS float*)F.lds; LAS float* VN = ST + 16 * 65;
    const bf16* GW = (const bf16*)(F.ws + WS_GW); const bf16* GU = (const bf16*)(F.ws + WS_GU); const bf16* GK = (const bf16*)(F.ws + WS_GK);
    const float* GD = (const float*)(F.ws + WS_GD);
    bf16* GS = (bf16*)(F.ws + WS_GS); bf16* GV = (bf16*)(F.ws + WS_GV);
    for (int u = F.bid; u < 256; u += F.G) {
        const int seq = u >> 2, vs = u & 3, dir = seq & 1;
        for (int i = F.tid; i < 16 * 65; i += NTHR) ST[i] = 0.f;
        __syncthreads();
#pragma unroll 1
        for (int st = 0; st < 68; ++st) {
            const int c = dir == 0 ? st : (st < 4 ? 3 - st : 71 - st);
            const size_t cb = ((size_t)seq * 68 + c) * 4096;
            const float dec = GD[seq * 68 + c];
            { const int pos = F.tid & 63, dvp = F.tid >> 6;
              float a0 = bf2f(GU[cb + pos * 64 + 16 * vs + 2 * dvp]), a1 = bf2f(GU[cb + pos * 64 + 16 * vs + 2 * dvp + 1]);
#pragma unroll
              for (int d8 = 0; d8 < 8; ++d8) { float w[8]; load8bf(GW + cb + pos * 64 + d8 * 8, w);
#pragma unroll
                  for (int j = 0; j < 8; ++j) { a0 -= w[j] * ST[(2 * dvp) * 65 + d8 * 8 + j]; a1 -= w[j] * ST[(2 * dvp + 1) * 65 + d8 * 8 + j]; } }
              VN[(2 * dvp) * 65 + pos] = a0; VN[(2 * dvp + 1) * 65 + pos] = a1;
              GV[cb + (size_t)(16 * vs + 2 * dvp) * 64 + pos] = (bf16)f2bf(a0); GV[cb + (size_t)(16 * vs + 2 * dvp + 1) * 64 + pos] = (bf16)f2bf(a1);
              GS[cb + (size_t)(16 * vs + 2 * dvp) * 64 + pos] = (bf16)f2bf(ST[(2 * dvp) * 65 + pos]); GS[cb + (size_t)(16 * vs + 2 * dvp + 1) * 64 + pos] = (bf16)f2bf(ST[(2 * dvp + 1) * 65 + pos]); }
            __syncthreads();
            { const int dk = F.tid & 63, dvp = F.tid >> 6;
              float s0 = ST[(2 * dvp) * 65 + dk] * dec, s1 = ST[(2 * dvp + 1) * 65 + dk] * dec;
#pragma unroll
              for (int p8 = 0; p8 < 8; ++p8) { float kk[8]; load8bf(GK + cb + dk * 64 + p8 * 8, kk);
#pragma unroll
                  for (int j = 0; j < 8; ++j) { s0 += kk[j] * VN[(2 * dvp) * 65 + p8 * 8 + j]; s1 += kk[j] * VN[(2 * dvp + 1) * 65 + p8 * 8 + j]; } }
              ST[(2 * dvp) * 65 + dk] = s0; ST[(2 * dvp + 1) * 65 + dk] = s1; }
            __syncthreads();
        }
    }
}
__device__ __forceinline__ void phase_G3(Frame& F, int l) {
    LAS float* qf = (LAS float*)F.lds; LAS float* kf = qf + 64 * 65; LAS float* at = kf + 64 * 65; LAS float* STl = at + 64 * 65; LAS float* VTl = STl + 64 * 65; LAS float* gcl = VTl + 64 * 65;
    const bf16* PA = (const bf16*)(F.ws + WS_PA); bf16* MIX = (bf16*)(F.ws + WS_HM);
    const bf16* GS = (const bf16*)(F.ws + WS_GS); const bf16* GV = (const bf16*)(F.ws + WS_GV); const float* GC = (const float*)(F.ws + WS_GC);
    const int c_lo = (l == 1) ? 4 : 0, nch = 68 - c_lo;
    for (int u = F.bid; u < 32 * nch; u += F.G) {
        const int bh = u / nch, c = c_lo + u % nch, b = bh >> 2, h = bh & 3;
        gdn_conv(F, l, qf, 65, b, h, c, 0);
        gdn_conv(F, l, kf, 65, b, h, c, 1);
        __syncthreads();
        l2norm_rows(F, qf, 65, 0.125f);
        l2norm_rows(F, kf, 65, 1.f);
        const int pos = F.tid >> 3, s8 = F.tid & 7;
        float o[8];
#pragma unroll
        for (int e = 0; e < 8; ++e) o[e] = 0.f;
#pragma unroll 1
        for (int dir = 0; dir < 2; ++dir) {
            const size_t cb = ((size_t)(bh * 2 + dir) * 68 + c) * 4096;
            __syncthreads();
            for (int i = F.tid; i < 4096; i += NTHR) { const int a = i >> 6, bq = i & 63; STl[a * 65 + bq] = bf2f(GS[cb + i]); VTl[a * 65 + bq] = bf2f(GV[cb + i]); }
            if (F.tid < 64) gcl[F.tid] = GC[((size_t)(bh * 2 + dir) * 68 + c) * 64 + F.tid];
            __syncthreads();
#pragma unroll 1
            for (int jj = 0; jj < 8; ++jj) { const int j = s8 + 8 * jj; float s = 0.f;
                for (int d = 0; d < 64; ++d) s += qf[pos * 65 + d] * kf[j * 65 + d];
                const bool ok = dir ? (j >= pos) : (j <= pos);
                at[pos * 65 + j] = ok ? s * __expf(gcl[pos] - gcl[j]) : 0.f; }
            __syncthreads();
            const float eg = __expf(gcl[pos]);
#pragma unroll
            for (int e = 0; e < 8; ++e) { const int dv = s8 * 8 + e; float s = 0.f;
                for (int d = 0; d < 64; ++d) s += qf[pos * 65 + d] * STl[dv * 65 + d];
                float s2 = 0.f;
                for (int j = 0; j < 64; ++j) s2 += at[pos * 65 + j] * VTl[dv * 65 + j];
                o[e] += s * eg + s2; }
        }
        float ss = 0.f;
#pragma unroll
        for (int e = 0; e < 8; ++e) ss += o[e] * o[e];
        ss += __shfl_xor(ss, 1); ss += __shfl_xor(ss, 2); ss += __shfl_xor(ss, 4);
        const float rr = 1.0f / sqrtf(ss * (1.f / 64.f) + EPSF);
        const int row = gdn_row(b, c, pos);
        float gt[8]; load8bf(PA + (size_t)row * 2048 + 1792 + h * 64 + s8 * 8, gt);
#pragma unroll
        for (int e = 0; e < 8; ++e) o[e] = o[e] * rr * F.in[IN_GNG][l * 64 + s8 * 8 + e] * silu_f(gt[e]);
        store8bf(MIX + (size_t)row * DM + 256 + h * 64 + s8 * 8, o);
        __syncthreads();
    }
}

constexpr int NPL = 12, PH_FINAL = 1 + 2 * NPL, NPHASES = PH_FINAL + 1;
struct Args { const float* in[24]; float* out; unsigned char* ws; int ph_lo, ph_hi; };

__global__ void __launch_bounds__(NTHR, 2) fwd(Args args) {
    extern __shared__ __attribute__((aligned(16))) unsigned char lds_raw[];
    Frame F;
    F.lds = (LAS unsigned char*)lds_raw;
    F.tid = threadIdx.x; F.lane = F.tid & 63; F.wave = __builtin_amdgcn_readfirstlane(F.tid >> 6); F.G = gridDim.x; F.bid = blockIdx.x;
    F.in = (const float* const __attribute__((address_space(4)))*)__builtin_amdgcn_kernarg_segment_ptr();
    F.out = args.out; F.ws = args.ws;
    volatile LAS unsigned* MISC = (volatile LAS unsigned*)(F.lds + MISC_OFF);
    if (F.tid < 16) MISC[F.tid] = 0u;
    __syncthreads();
    unsigned* ctl = (unsigned*)(F.ws + WS_CTL);
    const int lo = args.ph_lo, hi = args.ph_hi;
    XcdBarrier bar; bar.bar = ctl + CW_BAR; bar.x = 0; bar.st = nullptr;
    if (hi - lo > 1) bar = xcd_barrier_post(ctl + CW_BAR, MISC + 8);
#ifndef SITE_MASK
#define SITE_MASK 0xFFFFu
#endif
#define SITE(i) (((SITE_MASK) >> (i)) & 1u)
#define IN(k) (lo <= (k) && (k) < hi)
#define SEAM(k) do { if ((k) + 1 < hi) xcd_barrier(bar); } while (0)

    if (SITE(0) && IN(0)) { phase_prologue(F); SEAM(0); }

#pragma unroll 1
    for (int l = 0; l < 2; ++l) {
        const int pb = 1 + l * NPL;
        asm volatile("" : "+s"(F.bid), "+s"(F.G)); asm volatile("" : "+v"(F.tid));
        F.lane = F.tid & 63; F.wave = __builtin_amdgcn_readfirstlane(F.tid >> 6);
        const float* xl = l == 0 ? F.in[IN_X] : F.out;
        const float* xc = l == 0 ? F.in[IN_CTX] : (const float*)(F.ws + WS_XC);
        if (SITE(1) && IN(pb + 0)) { phase_norm(F, l, 0, xl, xc, MT); SEAM(pb + 0); }
        if (SITE(2) && IN(pb + 1)) {
            pg8::Gemm g{(const bf16*)(F.ws + WS_HM), (const bf16*)(F.ws + WS_WIN) + (size_t)l * NIN * DM, DM};
            pg8::SchedStatic S{MT / 256, NIN / 256, F.G, F.bid};
            pg8::EpiInProj E{(bf16*)(F.ws + WS_PA), (bf16*)(F.ws + WS_PB), (bf16*)(F.ws + WS_PC)};
            pg8::gemm_phase(F.lds, g, S, E, F.tid);
            SEAM(pb + 1);
        }
        if (SITE(3) && IN(pb + 2)) { phase_R1(F, l); phase_NA(F, l); SEAM(pb + 2); }
        if (SITE(4) && IN(pb + 3)) { phase_R2(F, l); phase_G1(F, l); SEAM(pb + 3); }
        if (SITE(5) && IN(pb + 4)) { phase_G2(F, l); SEAM(pb + 4); }
        if (SITE(6) && IN(pb + 5)) { phase_G3(F, l); phase_R3(F, l); SEAM(pb + 5); }
        if (SITE(7) && IN(pb + 6)) {
            pg8::Gemm g{(const bf16*)(F.ws + WS_HM), (const bf16*)(F.ws + WS_WOUT) + (size_t)l * DM * DM, DM};
            pg8::SchedStatic S{(l == 0 ? MT : NLAT) / 256, DM / 256, F.G, F.bid};
            pg8::EpiResGate E{xl, xc, F.out, (float*)(F.ws + WS_XC), (const float*)(F.ws + WS_MOD) + (size_t)(l * 9) * 6144 + 2 * 1024};
            pg8::gemm_phase(F.lds, g, S, E, F.tid);
            SEAM(pb + 6);
        }
        if (SITE(8) && IN(pb + 7)) {
            if (l == 0) phase_norm(F, l, 1, F.out, (const float*)(F.ws + WS_XC), MT);
            else { phase_norm_route(F, l, F.out); __syncthreads(); moe_weight_copy(F); }
            SEAM(pb + 7);
        }
        if (l == 0) {
            if (SITE(9) && IN(pb + 8)) {
                pg8::Gemm g{(const bf16*)(F.ws + WS_HM), (const bf16*)(F.ws + WS_W13D), DM};
                pg8::SchedStatic S{MT / 256, 2 * DFF / 256, F.G, F.bid};
                pg8::EpiSwiglu E{(bf16*)(F.ws + WS_ACTD)};
                pg8::gemm_phase(F.lds, g, S, E, F.tid);
                SEAM(pb + 8);
            }
            if (SITE(10) && IN(pb + 9)) {
                pg8::Gemm g{(const bf16*)(F.ws + WS_ACTD), (const bf16*)(F.ws + WS_W2D), DFF};
                pg8::SchedStatic S{MT / 256, DM / 256, F.G, F.bid};
                pg8::EpiResGate E{F.out, (const float*)(F.ws + WS_XC), F.out, (float*)(F.ws + WS_XC), (const float*)(F.ws + WS_MOD) + (size_t)(l * 9) * 6144 + 5 * 1024};
                pg8::gemm_phase(F.lds, g, S, E, F.tid);
                SEAM(pb + 9);
            }
        } else {
#pragma unroll 1
            for (int pass = 0; pass < 2; ++pass) {
                asm volatile("" : "+s"(F.bid), "+s"(F.G)); asm volatile("" : "+v"(F.tid));
                F.lane = F.tid & 63; F.wave = __builtin_amdgcn_readfirstlane(F.tid >> 6);
                const bool do_up = SITE(11) && IN(pb + 8 + 2 * pass), do_dn = SITE(12) && IN(pb + 9 + 2 * pass);
                if (do_up || do_dn) {
#define MOE_SCHED_INIT(S) do { const unsigned* gcnt = (const unsigned*)(F.ws + WS_CTL) + CW_CNT; int accT = 0; \
                        _Pragma("unroll") for (int e = 0; e < 8; ++e) { const int cn = (int)gcnt[e]; S.cn[e] = cn; S.ts[e] = accT; accT += (cn + 255) >> 8; } \
                        S.ts[8] = accT; S.t0 = pass * MOE_CAP_TILES; { int n = accT - S.t0; n = n < 0 ? 0 : n; S.nM = n > MOE_CAP_TILES ? MOE_CAP_TILES : n; } \
                        S.G = F.G; S.c = F.bid; S.tokslot = (const int*)(F.ws + WS_TOKSLOT); } while (0)
                    if (do_up) {
                        pg8::SchedMoe<true> S; MOE_SCHED_INIT(S);
                        S.nN = 2 * DFF / 256;
                        pg8::Gemm g{(const bf16*)(F.ws + WS_HM), (const bf16*)(F.ws + WS_MW13), DM};
                        pg8::EpiSwiglu E{(bf16*)(F.ws + WS_ACTM)};
                        pg8::gemm_phase(F.lds, g, S, E, F.tid);
                        SEAM(pb + 8 + 2 * pass);
                    }
                    if (do_dn) {
                        pg8::SchedMoe<false> S; MOE_SCHED_INIT(S);
                        S.nN = DM / 256;
                        pg8::Gemm g{(const bf16*)(F.ws + WS_ACTM), (const bf16*)(F.ws + WS_MW2), DFF};
                        pg8::EpiPlain E{(bf16*)(F.ws + WS_Y), DM};
                        pg8::gemm_phase(F.lds, g, S, E, F.tid);
                        SEAM(pb + 9 + 2 * pass);
                    }
                }
            }
        }
    }
    if (SITE(13) && IN(PH_FINAL)) phase_final(F);
#undef IN
#undef SEAM
}

extern "C" void kernel_launch(void* const* d_in, const int* in_sizes, int n_in, void* d_out, int out_size, void* d_ws, size_t ws_size, hipStream_t stream) {
    static int grid = 0;
    if (grid == 0) {
        if (n_in != 24 || out_size != NLAT * DM || ws_size < WS_NEED) { fprintf(stderr, "kernel_launch: unexpected problem: n_in %d out %d ws %zu (need %zu)\n", n_in, out_size, ws_size, (size_t)WS_NEED); grid = -1; return; }
        int dev = 0, cus = 0, per_cu = 0;
        if (hipGetDevice(&dev) != hipSuccess || hipDeviceGetAttribute(&cus, hipDeviceAttributeMultiprocessorCount, dev) != hipSuccess) { grid = -1; return; }
        if (hipFuncSetAttribute((const void*)fwd, hipFuncAttributeMaxDynamicSharedMemorySize, LDS_BYTES) != hipSuccess) { fprintf(stderr, "kernel_launch: hipFuncSetAttribute failed\n"); grid = -1; return; }
        if (hipOccupancyMaxActiveBlocksPerMultiprocessor(&per_cu, (const void*)fwd, NTHR, LDS_BYTES) != hipSuccess || per_cu < 1) { fprintf(stderr, "kernel_launch: occupancy query says %d\n", per_cu); }
        (void)hipGetLastError();
        grid = cus;
    }
    if (grid < 0) return;
    (void)hipMemsetAsync((char*)d_ws + WS_CTL, 0, CTL_ZERO_BYTES, stream);
    Args a{};
    for (int i = 0; i < 24; ++i) a.in[i] = (const float*)d_in[i];
    a.out = (float*)d_out; a.ws = (unsigned char*)d_ws;
#if MK_ONE_LAUNCH
    a.ph_lo = 0; a.ph_hi = NPHASES;
    hipLaunchKernelGGL(fwd, dim3(grid), dim3(NTHR), LDS_BYTES, stream, a);
#else
    for (int p = 0; p < NPHASES; ++p) {
        if (p >= 1 + 10 && p < 1 + NPL) continue;
        a.ph_lo = p; a.ph_hi = p + 1;
        hipLaunchKernelGGL(fwd, dim3(grid), dim3(NTHR), LDS_BYTES, stream, a);
    }
#endif
}
```
